# Optimizing an MI355X kernel written in HIP

```python
import jax, jax.numpy as jnp
from jax import lax
import numpy as np

D_MODEL = 2048
BATCH = 4
SEQ = 2048
DEPTH = 1
DEC_BATCH = 128
DEC_SEQ = 1
PAST_LEN = 16384
PAGE_SIZE = 128

MIX_DIM = D_MODEL
CONV_DIM = MIX_DIM // 2
POOL_DIM = MIX_DIM - CONV_DIM
POOL_WINDOWS = (2, 4, 8, 16)
N_POOL_GROUPS = len(POOL_WINDOWS)
POOL_GROUP_DIM = POOL_DIM // N_POOL_GROUPS
POOL_CTX = max(POOL_WINDOWS) - 1
CONV_WIDTH = 31
CONV_CTX = CONV_WIDTH - 1
PROJ_IN = 2 * CONV_DIM + POOL_DIM
D_FF = ((8 * D_MODEL // 3 + 255) // 256) * 256
PLE_DIM = 256
EPS = 1e-6

kernel_name = "hymba_conv_pool_macaron_decoder_step"


def _rmsnorm(x, g):
    xf = x.astype(jnp.float32)
    xf = xf * lax.rsqrt(jnp.mean(xf * xf, axis=-1, keepdims=True) + EPS)
    return (xf * g.astype(jnp.float32)).astype(x.dtype)


def _layernorm(x, g, b):
    xf = x.astype(jnp.float32)
    mu = jnp.mean(xf, axis=-1, keepdims=True)
    var = jnp.mean(jnp.square(xf - mu), axis=-1, keepdims=True)
    y = (xf - mu) * lax.rsqrt(var + EPS) * g.astype(jnp.float32) + b.astype(jnp.float32)
    return y.astype(x.dtype)


def _swiglu(h, w_in, w_out):
    gu = h @ w_in
    gate, up = gu[..., :D_FF], gu[..., D_FF:]
    return (jax.nn.silu(gate) * up) @ w_out


def _conv_group(a_val, a_gate, conv_buf, conv_w, conv_b, conv_ln_g, conv_ln_b):
    v = a_val * jax.nn.sigmoid(a_gate)
    v_ext = jnp.concatenate([conv_buf.astype(v.dtype), v], axis=1)
    out = lax.conv_general_dilated(
        v_ext, conv_w[:, None, :].astype(v.dtype), window_strides=(1,), padding="VALID",
        dimension_numbers=("NWC", "WIO", "NWC"), feature_group_count=CONV_DIM)
    out = out + conv_b
    out = jax.nn.silu(_layernorm(out, conv_ln_g, conv_ln_b))
    return out, v_ext[:, -CONV_CTX:]


def _pool_group(u, pool_buf, pos0, pool_w, pool_scale):
    B, T, _ = u.shape
    u_ext = jnp.concatenate([pool_buf.astype(u.dtype), u], axis=1)
    c = jnp.cumsum(u_ext.astype(jnp.float32), axis=1)
    c = jnp.pad(c, ((0, 0), (1, 0), (0, 0)))
    pos = pos0 + jnp.arange(T, dtype=jnp.int32)
    uf = u.astype(jnp.float32)
    outs = []
    for g, w in enumerate(POOL_WINDOWS):
        sl = slice(g * POOL_GROUP_DIM, (g + 1) * POOL_GROUP_DIM)
        s = c[:, 1 + POOL_CTX:1 + POOL_CTX + T, sl] - c[:, 1 + POOL_CTX - w:1 + POOL_CTX - w + T, sl]
        cnt = jnp.minimum(pos + 1, w).astype(jnp.float32)[None, :, None]
        outs.append(s / cnt - uf[..., sl])
    d = jnp.stack(outs, axis=2).astype(u.dtype)
    y = jnp.einsum("btgc,gcd->btgd", d, pool_w).reshape(B, T, POOL_DIM)
    return y * pool_scale, u_ext[:, -POOL_CTX:]


def _layer(x, p, conv_buf, pool_buf, pos0,
           norm_ffn1, w_ffn1_in, w_ffn1_out, norm_mix, w_in, conv_w, conv_b, conv_ln_g, conv_ln_b,
           pool_w, pool_scale, w_out, norm_ffn2, w_ffn2_in, w_ffn2_out, norm_ple, w_ple_gate, w_ple_proj):
    x = x + 0.5 * _swiglu(_rmsnorm(x, norm_ffn1), w_ffn1_in, w_ffn1_out)
    h = _rmsnorm(x, norm_mix)
    proj = h @ w_in
    a_val = proj[..., :CONV_DIM]
    a_gate = proj[..., CONV_DIM:2 * CONV_DIM]
    u_pool = proj[..., 2 * CONV_DIM:]
    conv_out, new_conv = _conv_group(a_val, a_gate, conv_buf, conv_w, conv_b, conv_ln_g, conv_ln_b)
    pool_out, new_pool = _pool_group(u_pool, pool_buf, pos0, pool_w, pool_scale)
    x = x + jnp.concatenate([conv_out, pool_out], axis=-1) @ w_out
    x = x + 0.5 * _swiglu(_rmsnorm(x, norm_ffn2), w_ffn2_in, w_ffn2_out)
    gate = jax.nn.sigmoid(_rmsnorm(x, norm_ple) @ w_ple_gate)
    x = x + gate * (p @ w_ple_proj)
    return x, new_conv, new_pool


def setup_inputs(seed: int = 0) -> dict:
    key = jax.random.key(seed)
    ks = jax.random.split(key, 32)
    f32 = jnp.float32

    def nrm(k, shape, scale):
        return jax.random.normal(k, shape, f32) * scale

    def gain(k, shape):
        return 1.0 + 0.02 * jax.random.normal(k, shape, f32)

    return {
        "x_prompt": nrm(ks[0], (BATCH, SEQ, D_MODEL), 1.0),
        "x_sample": nrm(ks[1], (DEC_BATCH, DEC_SEQ, D_MODEL), 1.0),
        "state_conv": nrm(ks[2], (DEPTH, DEC_BATCH, CONV_CTX, CONV_DIM), 0.5),
        "state_pool": nrm(ks[3], (DEPTH, DEC_BATCH, POOL_CTX, POOL_DIM), 1.0),
        "p_prompt": nrm(ks[4], (DEPTH, BATCH, SEQ, PLE_DIM), 1.0),
        "p_sample": nrm(ks[5], (DEPTH, DEC_BATCH, DEC_SEQ, PLE_DIM), 1.0),
        "norm_ffn1": gain(ks[6], (DEPTH, D_MODEL)),
        "w_ffn1_in": nrm(ks[7], (DEPTH, D_MODEL, 2 * D_FF), D_MODEL ** -0.5),
        "w_ffn1_out": nrm(ks[8], (DEPTH, D_FF, D_MODEL), D_FF ** -0.5),
        "norm_mix": gain(ks[9], (DEPTH, D_MODEL)),
        "w_in": nrm(ks[10], (DEPTH, D_MODEL, PROJ_IN), D_MODEL ** -0.5),
        "conv_w": nrm(ks[11], (DEPTH, CONV_WIDTH, CONV_DIM), CONV_WIDTH ** -0.5),
        "conv_b": nrm(ks[12], (DEPTH, CONV_DIM), 0.02),
        "conv_ln_g": gain(ks[13], (DEPTH, CONV_DIM)),
        "conv_ln_b": nrm(ks[14], (DEPTH, CONV_DIM), 0.02),
        "pool_w": nrm(ks[15], (DEPTH, N_POOL_GROUPS, POOL_GROUP_DIM, POOL_GROUP_DIM), POOL_GROUP_DIM ** -0.5),
        "pool_scale": gain(ks[16], (DEPTH, POOL_DIM)),
        "w_out": nrm(ks[17], (DEPTH, MIX_DIM, D_MODEL), MIX_DIM ** -0.5),
        "norm_ffn2": gain(ks[18], (DEPTH, D_MODEL)),
        "w_ffn2_in": nrm(ks[19], (DEPTH, D_MODEL, 2 * D_FF), D_MODEL ** -0.5),
        "w_ffn2_out": nrm(ks[20], (DEPTH, D_FF, D_MODEL), D_FF ** -0.5),
        "norm_ple": gain(ks[21], (DEPTH, D_MODEL)),
        "w_ple_gate": nrm(ks[22], (DEPTH, D_MODEL, D_MODEL), D_MODEL ** -0.5),
        "w_ple_proj": nrm(ks[23], (DEPTH, PLE_DIM, D_MODEL), PLE_DIM ** -0.5),
        "norm_final": gain(ks[24], (D_MODEL,)),
    }


def reference(x_prompt, x_sample, state_conv, state_pool, p_prompt, p_sample,
              norm_ffn1, w_ffn1_in, w_ffn1_out, norm_mix, w_in, conv_w, conv_b, conv_ln_g, conv_ln_b,
              pool_w, pool_scale, w_out, norm_ffn2, w_ffn2_in, w_ffn2_out, norm_ple, w_ple_gate,
              w_ple_proj, norm_final):
    xp, xs = x_prompt, x_sample
    conv_p_list, conv_s_list, pool_p_list, pool_s_list = [], [], [], []
    for i in range(DEPTH):
        weights = (norm_ffn1[i], w_ffn1_in[i], w_ffn1_out[i], norm_mix[i], w_in[i], conv_w[i], conv_b[i],
                   conv_ln_g[i], conv_ln_b[i], pool_w[i], pool_scale[i], w_out[i], norm_ffn2[i],
                   w_ffn2_in[i], w_ffn2_out[i], norm_ple[i], w_ple_gate[i], w_ple_proj[i])
        zero_conv = jnp.zeros((xp.shape[0], CONV_CTX, CONV_DIM), xp.dtype)
        zero_pool = jnp.zeros((xp.shape[0], POOL_CTX, POOL_DIM), xp.dtype)
        xp, cp, pp = _layer(xp, p_prompt[i], zero_conv, zero_pool, 0, *weights)
        xs, cs, ps = _layer(xs, p_sample[i], state_conv[i], state_pool[i], PAST_LEN, *weights)
        conv_p_list.append(cp)
        conv_s_list.append(cs)
        pool_p_list.append(pp)
        pool_s_list.append(ps)
    y_prompt = _rmsnorm(xp, norm_final)
    y_sample = _rmsnorm(xs, norm_final)
    new_conv_prompt = jnp.stack(conv_p_list, axis=0)
    new_conv_sample = jnp.stack(conv_s_list, axis=0)
    new_pool_prompt = jnp.stack(pool_p_list, axis=0)
    new_pool_sample = jnp.stack(pool_s_list, axis=0)
    return (y_prompt, y_sample, new_conv_prompt, new_conv_sample, new_pool_prompt, new_pool_sample)
```

```cpp
#include <hip/hip_runtime.h>
#include <hip/hip_cooperative_groups.h>
#include <cstdio>
#include <cstdint>
namespace cg = cooperative_groups;

#ifndef MK_N_LAUNCHES
#define MK_N_LAUNCHES 11
#endif

#define LAS __attribute__((address_space(3)))
#define GAS __attribute__((address_space(1)))
typedef unsigned short bf16_t;
typedef short bf16x8 __attribute__((ext_vector_type(8)));
typedef float f32x4 __attribute__((ext_vector_type(4)));
typedef float f32x2 __attribute__((ext_vector_type(2)));
typedef unsigned u32x4 __attribute__((ext_vector_type(4)));
typedef unsigned u32x2 __attribute__((ext_vector_type(2)));

constexpr int D = 2048, DFF = 5632, NPROMPT = 8192, NSAMP = 128, NTOK = NPROMPT + NSAMP, MP = 8448  , SEQ = 2048;
constexpr int CDIM = 1024, PDIM = 1024, PLE = 256, NBATCH = 4;
constexpr float EPS = 1e-6f;
constexpr int NWAVES = 8, NTHREADS = 512;

constexpr size_t WS_CTL = 0, CTL_BYTES = 65536;
constexpr size_t WS_W1IN = WS_CTL + CTL_BYTES;
constexpr size_t WS_W1OUT = WS_W1IN + (size_t)2 * DFF * D * 2;
constexpr size_t WS_W2IN = WS_W1OUT + (size_t)D * DFF * 2;
constexpr size_t WS_W2OUT = WS_W2IN + (size_t)2 * DFF * D * 2;
constexpr size_t WS_WIN = WS_W2OUT + (size_t)D * DFF * 2;
constexpr size_t WS_WOUT = WS_WIN + (size_t)3072 * D * 2;
constexpr size_t WS_WPG = WS_WOUT + (size_t)D * D * 2;
constexpr size_t WS_WPP = WS_WPG + (size_t)D * D * 2;
constexpr size_t WS_PW = WS_WPP + (size_t)D * PLE * 2;
constexpr size_t WS_XNB = WS_PW + (size_t)4 * 256 * 256 * 2;
constexpr size_t WS_ACT = WS_XNB + (size_t)MP * D * 2;
constexpr size_t WS_V = WS_ACT, WS_U = WS_ACT + (size_t)MP * CDIM * 4;
constexpr size_t WS_MIX = WS_ACT + (size_t)MP * DFF * 2;
constexpr size_t WS_PP = WS_MIX + (size_t)MP * D * 2;
constexpr size_t WS_PB = WS_PP + (size_t)MP * D * 2;
constexpr size_t WS_SS = WS_PB + (size_t)MP * PLE * 2;
constexpr size_t WS_END = WS_SS + (size_t)5 * MP * 4;
static_assert(WS_U + (size_t)MP * PDIM * 4 <= WS_ACT + (size_t)NTOK * DFF * 2, "V/U overlay must not reach the act pad rows");

constexpr size_t OUT_Y = 0, OUT_NCP = (size_t)NTOK * D, OUT_NCS = OUT_NCP + (size_t)NBATCH * 30 * CDIM, OUT_NPP = OUT_NCS + (size_t)NSAMP * 30 * CDIM,
                 OUT_NPS = OUT_NPP + (size_t)NBATCH * 15 * PDIM, OUT_END = OUT_NPS + (size_t)NSAMP * 15 * PDIM;

__device__ __forceinline__ unsigned cvt_pk_bf16(float lo, float hi) { unsigned r; asm volatile("v_cvt_pk_bf16_f32 %0, %1, %2" : "=v"(r) : "v"(lo), "v"(hi)); return r; }
__device__ __forceinline__ float bf_lo(unsigned w) { return __uint_as_float(w << 16); }
__device__ __forceinline__ float bf_hi(unsigned w) { return __uint_as_float(w & 0xffff0000u); }
__device__ __forceinline__ float sigmoidf_fast(float x) { return __builtin_amdgcn_rcpf(1.0f + __builtin_amdgcn_exp2f(-1.44269504089f * x)); }
__device__ __forceinline__ float wave_sum(float v) {
#pragma unroll
    for (int o = 1; o < 64; o <<= 1) v += __shfl_xor(v, o);
    return v;
}
#define LDS_WAIT() asm volatile("s_waitcnt lgkmcnt(0)" ::: "memory")
#define VM_WAIT() asm volatile("s_waitcnt vmcnt(0)" ::: "memory")

namespace pg8 {
constexpr int BM = 256, BK = 64, HALF = 128, HTB = HALF * BK * 2  , STAGE_BYTES = 8 * HTB, NXCD = 8, WGM = 8;
__host__ __device__ __forceinline__ int lds_byte(int r, int c) { const int st = (r >> 4) * 2 + (c >> 5), rr = r & 15, cc = c & 31, ob = rr * 64 + cc * 2; return st * 1024 + (ob ^ (((ob >> 9) & 1) << 5)); }
__host__ __device__ __forceinline__ void stage_rc(int b, int& R, int& C) { const int st = b / 1024, sb = b % 1024, swz = sb ^ (((sb >> 9) & 1) << 5); R = (st >> 1) * 16 + swz / 64; C = (st & 1) * 32 + (swz % 64) / 2; }
__host__ __device__ __forceinline__ int perm32(int rho) { const int n = rho >> 4, i = rho & 15; return 8 * (i >> 2) + 4 * n + (i & 3); }

struct Unit { int pm, pn; };
struct Gemm { const bf16_t* A; const bf16_t* Bt; int M, N, K; };

struct StaticOrder {
    int nM, nN, nwg, G, c;
    __host__ __device__ void init(int M, int N, int G_, int c_) { nM = M / BM; nN = N / BM; nwg = nM * nN; G = G_; c = c_; }
    __host__ __device__ bool next(int i, Unit& u) const {
        const long L = (long)i * G + c; if (L >= nwg) return false;
        int wgid = (int)L; { const int q = nwg / NXCD, r = nwg % NXCD, xcd = wgid % NXCD, off = wgid / NXCD; wgid = (xcd < r ? xcd * (q + 1) : r * (q + 1) + (xcd - r) * q) + off; }
        const int nig = WGM * nN, gid = wgid / nig, fm = gid * WGM, gsz = (nM - fm) < WGM ? (nM - fm) : WGM;
        u.pm = fm + ((wgid % nig) % gsz); u.pn = (wgid % nig) / gsz; return true;
    }
    __device__ __forceinline__ void a_ready(const Unit&) const {}
    __device__ __forceinline__ void done(const Unit&) const {}
};

enum { EP_SWIGLU = 0, EP_RESID = 1, EP_WIN = 2, EP_PP = 3, EP_PLE = 4 };
template <int MODE> struct Epi {
    static constexpr bool PERM = true, AFTER_DRAIN = false;
    const float* ss_in;
    float* ss_out;
    const float* res0;
    const float* res1;
    float* outf;
    bf16_t* outb;
    float* V; float* U;
    const bf16_t* pp;
    float scale;
    __device__ __forceinline__ void operator()(const f32x4 (&acc)[2][2][4][2], const Unit& u, int wr, int wc, int fr, int fq) const {
        const int rowb = u.pm * BM + wr * 64 + fr;
        const int cw = wc * 32 + 8 * fq;
#pragma unroll
        for (int ai = 0; ai < 2; ++ai) {
            if (u.pm * BM + ai * HALF >= NTOK) continue;
#pragma unroll
            for (int m = 0; m < 4; ++m) {
                const int r = rowb + ai * HALF + m * 16;
                float rs = 1.0f;
                if (MODE == EP_SWIGLU || MODE == EP_WIN || MODE == EP_PLE) rs = __builtin_amdgcn_rsqf(ss_in[r] * (1.0f / D) + EPS);
                if (MODE == EP_SWIGLU) {
                    f32x4 a[2];
#pragma unroll
                    for (int n = 0; n < 2; ++n)
#pragma unroll
                        for (int j = 0; j < 4; ++j) { const float g = acc[ai][0][m][n][j] * rs, up = acc[ai][1][m][n][j] * rs; a[n][j] = g * sigmoidf_fast(g) * up; }
                    u32x4 w; w.x = cvt_pk_bf16(a[0][0], a[0][1]); w.y = cvt_pk_bf16(a[0][2], a[0][3]); w.z = cvt_pk_bf16(a[1][0], a[1][1]); w.w = cvt_pk_bf16(a[1][2], a[1][3]);
                    *(u32x4*)(outb + (size_t)r * DFF + u.pn * HALF + cw) = w;
                } else if (MODE == EP_RESID) {
                    const float* rp = (u.pm < NPROMPT / BM ? res0 + (size_t)r * D : res1 + (size_t)(r - NPROMPT) * D) + u.pn * BM + cw;
                    float* op = outf + (size_t)r * D + u.pn * BM + cw; bf16_t* ob = outb + (size_t)r * D + u.pn * BM + cw;
                    float sq = 0.f;
#pragma unroll
                    for (int bj = 0; bj < 2; ++bj) {
                        const f32x4 x0 = *(const f32x4*)(rp + bj * HALF), x1 = *(const f32x4*)(rp + bj * HALF + 4);
                        const f32x4 y0 = x0 + acc[ai][bj][m][0] * scale, y1 = x1 + acc[ai][bj][m][1] * scale;
                        *(f32x4*)(op + bj * HALF) = y0; *(f32x4*)(op + bj * HALF + 4) = y1;
                        u32x4 w; w.x = cvt_pk_bf16(y0[0], y0[1]); w.y = cvt_pk_bf16(y0[2], y0[3]); w.z = cvt_pk_bf16(y1[0], y1[1]); w.w = cvt_pk_bf16(y1[2], y1[3]);
                        *(u32x4*)(ob + bj * HALF) = w;
                        sq += (y0[0] * y0[0] + y0[1] * y0[1]) + (y0[2] * y0[2] + y0[3] * y0[3]) + (y1[0] * y1[0] + y1[1] * y1[1]) + (y1[2] * y1[2] + y1[3] * y1[3]);
                    }
                    sq += __shfl_xor(sq, 16); sq += __shfl_xor(sq, 32);
                    if (fq == 0) unsafeAtomicAdd(ss_out + r, sq);
                } else if (MODE == EP_WIN) {
                    if (u.pn < 8) {
                        float* vp = V + (size_t)r * CDIM + u.pn * HALF + cw;
#pragma unroll
                        for (int n = 0; n < 2; ++n) { f32x4 o;
#pragma unroll
                            for (int j = 0; j < 4; ++j) o[j] = (acc[ai][0][m][n][j] * rs) * sigmoidf_fast(acc[ai][1][m][n][j] * rs);
                            *(f32x4*)(vp + 4 * n) = o; }
                    } else {
                        float* upt = U + (size_t)r * PDIM + (u.pn - 8) * BM + cw;
#pragma unroll
                        for (int bj = 0; bj < 2; ++bj)
#pragma unroll
                            for (int n = 0; n < 2; ++n) *(f32x4*)(upt + bj * HALF + 4 * n) = acc[ai][bj][m][n] * rs;
                    }
                } else if (MODE == EP_PP) {
                    bf16_t* ob = outb + (size_t)r * D + u.pn * BM + cw;
#pragma unroll
                    for (int bj = 0; bj < 2; ++bj) { const f32x4 y0 = acc[ai][bj][m][0], y1 = acc[ai][bj][m][1];
                        u32x4 w; w.x = cvt_pk_bf16(y0[0], y0[1]); w.y = cvt_pk_bf16(y0[2], y0[3]); w.z = cvt_pk_bf16(y1[0], y1[1]); w.w = cvt_pk_bf16(y1[2], y1[3]);
                        *(u32x4*)(ob + bj * HALF) = w; }
                } else {
                    float* op = outf + (size_t)r * D + u.pn * BM + cw; const bf16_t* pb = pp + (size_t)r * D + u.pn * BM + cw;
                    float sq = 0.f;
#pragma unroll
                    for (int bj = 0; bj < 2; ++bj) {
                        const f32x4 x0 = *(const f32x4*)(op + bj * HALF), x1 = *(const f32x4*)(op + bj * HALF + 4);
                        const u32x4 pw = *(const u32x4*)(pb + bj * HALF);
                        const f32x4 p0 = {bf_lo(pw.x), bf_hi(pw.x), bf_lo(pw.y), bf_hi(pw.y)}, p1 = {bf_lo(pw.z), bf_hi(pw.z), bf_lo(pw.w), bf_hi(pw.w)};
                        f32x4 y0, y1;
#pragma unroll
                        for (int j = 0; j < 4; ++j) { y0[j] = x0[j] + sigmoidf_fast(acc[ai][bj][m][0][j] * rs) * p0[j]; y1[j] = x1[j] + sigmoidf_fast(acc[ai][bj][m][1][j] * rs) * p1[j]; }
                        *(f32x4*)(op + bj * HALF) = y0; *(f32x4*)(op + bj * HALF + 4) = y1;
                        sq += (y0[0] * y0[0] + y0[1] * y0[1]) + (y0[2] * y0[2] + y0[3] * y0[3]) + (y1[0] * y1[0] + y1[1] * y1[1]) + (y1[2] * y1[2] + y1[3] * y1[3]);
                    }
                    sq += __shfl_xor(sq, 16); sq += __shfl_xor(sq, 32);
                    if (fq == 0) unsafeAtomicAdd(ss_out + r, sq);
                }
            }
        }
    }
};

template <class Epi, class Sched, bool ALIGN_EPI = true, bool SP2 = true>
__device__ __forceinline__ void gemm_phase(LAS unsigned char* lds, const Gemm g, const Sched& S, const Epi& E) {
    int tid_ = threadIdx.x; asm volatile("" : "+v"(tid_));
    const int tid = tid_, wid = __builtin_amdgcn_readfirstlane(tid >> 6), lane = tid & 63, wr = wid >> 2, wc = wid & 3, fr = lane & 15, fq = lane >> 4;
    const int K = g.K, nt = K / BK;
    unsigned voffA[2], voffB[2];
#pragma unroll
    for (int i = 0; i < 2; ++i) { int R, C; stage_rc(tid * 16 + i * 8192, R, C); const int Rb = Epi::PERM ? ((R & ~31) + perm32(R & 31)) : R;
        voffA[i] = (unsigned)(R * K + C) * 2u; voffB[i] = (unsigned)(Rb * K + C) * 2u; }
    const size_t kstep = (size_t)(BK * 2);
    const size_t hstep = (size_t)HALF * K * 2;
    const size_t tstep = 2 * hstep;
    const unsigned ldsw = (unsigned)wid * 1024u;
    const int aoff = lds_byte(wr * 64 + fr, fq * 8), boff = lds_byte(wc * 32 + fr, fq * 8);
#define PG8_SA(b, h) (((b) * 2 + (h)) * HTB)
#define PG8_SB(b, h) ((4 + (b) * 2 + (h)) * HTB)
#define PG8_STAGE(bufoff, gbase, voff) do { _Pragma("unroll") for (int _i = 0; _i < 2; ++_i) \
        __builtin_amdgcn_global_load_lds((const unsigned*)((const char*)(gbase) + (voff)[_i]), (LAS unsigned*)(lds + (bufoff) + ldsw + _i * 8192), 16, 0, 0); } while (0)
#define PG8_LDA(dst, b, h) do { _Pragma("unroll") for (int m = 0; m < 4; ++m) _Pragma("unroll") for (int k = 0; k < 2; ++k) dst[m][k] = *(const LAS bf16x8*)(lds + PG8_SA(b, h) + aoff + m * 2048 + k * 1024); } while (0)
#define PG8_LDB(dst, b, h) do { _Pragma("unroll") for (int n = 0; n < 2; ++n) _Pragma("unroll") for (int k = 0; k < 2; ++k) dst[n][k] = *(const LAS bf16x8*)(lds + PG8_SB(b, h) + boff + n * 2048 + k * 1024); } while (0)
#define PG8_MMA(ai, bj, At, Bt) do { __builtin_amdgcn_s_setprio(1); _Pragma("unroll") for (int m = 0; m < 4; ++m) _Pragma("unroll") for (int n = 0; n < 2; ++n) _Pragma("unroll") for (int k = 0; k < 2; ++k) \
        acc[ai][bj][m][n] = __builtin_amdgcn_mfma_f32_16x16x32_bf16(Bt[n][k], At[m][k], acc[ai][bj][m][n], 0, 0, 0); __builtin_amdgcn_s_setprio(0); } while (0)
#define PG8_WAIT_V(n) asm volatile("s_waitcnt vmcnt(" #n ")" ::: "memory")
#define PG8_WAIT_L(n) asm volatile("s_waitcnt lgkmcnt(" #n ")" ::: "memory")
#define PG8_BAR __builtin_amdgcn_s_barrier()
#define PG8_SCHED __builtin_amdgcn_sched_barrier(0)
    Unit cur, nxt; int ui = 0;
    if (!S.next(0, cur)) return;
    f32x4 acc[2][2][4][2];
#pragma unroll
    for (int a = 0; a < 2; ++a)
#pragma unroll
        for (int b = 0; b < 2; ++b)
#pragma unroll
            for (int m = 0; m < 4; ++m)
#pragma unroll
                for (int n = 0; n < 2; ++n) acc[a][b][m][n] = (f32x4){0.f, 0.f, 0.f, 0.f};
    bf16x8 At[4][2], B0[2][2], B1[2][2];
    const char* cA = (const char*)g.A + (size_t)cur.pm * tstep; const char* cB = (const char*)g.Bt + (size_t)cur.pn * tstep;
    S.a_ready(cur);
    if constexpr (SP2) {
        PG8_STAGE(PG8_SB(0, 0), cB, voffB); PG8_STAGE(PG8_SB(0, 1), cB + hstep, voffB); PG8_STAGE(PG8_SA(0, 0), cA, voffA); PG8_STAGE(PG8_SA(0, 1), cA + hstep, voffA);
        if (wr == 1) PG8_BAR;
        PG8_WAIT_V(2); PG8_BAR;
        PG8_STAGE(PG8_SB(1, 0), cB + kstep, voffB); PG8_STAGE(PG8_SA(1, 0), cA + kstep, voffA); PG8_STAGE(PG8_SB(1, 1), cB + hstep + kstep, voffB);
        PG8_WAIT_V(6); PG8_BAR;
    } else {
        PG8_STAGE(PG8_SB(0, 0), cB, voffB); PG8_STAGE(PG8_SA(0, 0), cA, voffA); PG8_STAGE(PG8_SB(0, 1), cB + hstep, voffB); PG8_STAGE(PG8_SA(0, 1), cA + hstep, voffA);
        if (wr == 1) PG8_BAR;
        PG8_WAIT_V(4); PG8_BAR;
        PG8_STAGE(PG8_SB(1, 0), cB + kstep, voffB); PG8_STAGE(PG8_SA(1, 0), cA + kstep, voffA); PG8_STAGE(PG8_SB(1, 1), cB + hstep + kstep, voffB);
        PG8_WAIT_V(6); PG8_BAR;
    }
    for (;;) {
        const bool has_next = S.next(ui + 1, nxt);
        const char* nA = has_next ? (const char*)g.A + (size_t)nxt.pm * tstep : cA; const char* nB = has_next ? (const char*)g.Bt + (size_t)nxt.pn * tstep : cB;
#pragma nounroll
        for (int t = 0; t < nt; t += 2) {
            const bool last = (t == nt - 2);
            const char* a1 = cA + (size_t)(t + 1) * kstep;
            const char* a2 = last ? nA : cA + (size_t)(t + 2) * kstep; const char* b2 = last ? nB : cB + (size_t)(t + 2) * kstep;
            const char* a3 = a2 + kstep; const char* b3 = b2 + kstep;
            if (last && has_next) S.a_ready(nxt);
            if constexpr (SP2) {
            PG8_LDB(B0, 0, 0); PG8_LDB(B1, 0, 1); PG8_SCHED; PG8_LDA(At, 0, 0); PG8_STAGE(PG8_SA(1, 1), a1 + hstep, voffA);
            PG8_WAIT_V(8); PG8_WAIT_L(0); PG8_BAR; PG8_MMA(0, 0, At, B0); PG8_MMA(0, 1, At, B1); PG8_BAR; PG8_SCHED;
            PG8_LDA(At, 0, 1); PG8_STAGE(PG8_SB(0, 0), b2, voffB); PG8_STAGE(PG8_SB(0, 1), b2 + hstep, voffB); PG8_STAGE(PG8_SA(0, 0), a2, voffA);
            PG8_WAIT_V(8); PG8_WAIT_L(0); PG8_BAR; PG8_MMA(1, 0, At, B0); PG8_MMA(1, 1, At, B1); PG8_BAR; PG8_SCHED;
            PG8_LDB(B0, 1, 0); PG8_LDB(B1, 1, 1); PG8_SCHED; PG8_LDA(At, 1, 0); PG8_STAGE(PG8_SA(0, 1), a2 + hstep, voffA);
            PG8_WAIT_V(8); PG8_WAIT_L(0); PG8_BAR; PG8_MMA(0, 0, At, B0); PG8_MMA(0, 1, At, B1); PG8_BAR; PG8_SCHED;
            PG8_LDA(At, 1, 1); PG8_STAGE(PG8_SB(1, 0), b3, voffB); PG8_STAGE(PG8_SB(1, 1), b3 + hstep, voffB); PG8_STAGE(PG8_SA(1, 0), a3, voffA);
            PG8_WAIT_V(8); PG8_WAIT_L(0); PG8_BAR; PG8_MMA(1, 0, At, B0); PG8_MMA(1, 1, At, B1); PG8_BAR; PG8_SCHED;
            } else {
            PG8_LDB(B0, 0, 0); PG8_SCHED; PG8_LDA(At, 0, 0); PG8_STAGE(PG8_SA(1, 1), a1 + hstep, voffA);
            PG8_WAIT_L(8); PG8_BAR; PG8_WAIT_L(0); PG8_MMA(0, 0, At, B0); PG8_BAR; PG8_SCHED;
            PG8_LDB(B1, 0, 1); PG8_STAGE(PG8_SB(0, 0), b2, voffB);
            PG8_BAR; PG8_WAIT_L(0); PG8_MMA(0, 1, At, B1); PG8_BAR;
            PG8_LDA(At, 0, 1); PG8_STAGE(PG8_SA(0, 0), a2, voffA);
            PG8_BAR; PG8_WAIT_L(0); PG8_MMA(1, 0, At, B0); PG8_BAR; PG8_SCHED;
            PG8_STAGE(PG8_SB(0, 1), b2 + hstep, voffB);
            PG8_WAIT_V(6); PG8_BAR; PG8_MMA(1, 1, At, B1); PG8_BAR;
            PG8_LDB(B0, 1, 0); PG8_SCHED; PG8_LDA(At, 1, 0); PG8_STAGE(PG8_SA(0, 1), a2 + hstep, voffA);
            PG8_WAIT_L(8); PG8_BAR; PG8_WAIT_L(0); PG8_MMA(0, 0, At, B0); PG8_BAR; PG8_SCHED;
            PG8_LDB(B1, 1, 1); PG8_STAGE(PG8_SB(1, 0), b3, voffB);
            PG8_BAR; PG8_WAIT_L(0); PG8_MMA(0, 1, At, B1); PG8_BAR;
            PG8_LDA(At, 1, 1); PG8_STAGE(PG8_SA(1, 0), a3, voffA);
            PG8_BAR; PG8_WAIT_L(0); PG8_MMA(1, 0, At, B0); PG8_BAR; PG8_SCHED;
            PG8_STAGE(PG8_SB(1, 1), b3 + hstep, voffB);
            PG8_WAIT_V(6); PG8_BAR; PG8_MMA(1, 1, At, B1); PG8_BAR;
            }
        }
        if constexpr (ALIGN_EPI) { if (wr == 0) PG8_BAR; }
        if constexpr (!Epi::AFTER_DRAIN) { E(acc, cur, wr, wc, fr, fq); S.done(cur); }
        if (!has_next) break;
#pragma unroll
        for (int a = 0; a < 2; ++a)
#pragma unroll
            for (int b = 0; b < 2; ++b)
#pragma unroll
                for (int m = 0; m < 4; ++m)
#pragma unroll
                    for (int n = 0; n < 2; ++n) acc[a][b][m][n] = (f32x4){0.f, 0.f, 0.f, 0.f};
        cur = nxt; cA = nA; cB = nB; ++ui;
        if constexpr (ALIGN_EPI) { if (wr == 1) PG8_BAR; }
    }
    PG8_WAIT_V(0);
    if constexpr (!ALIGN_EPI) { if (wr == 0) PG8_BAR; }
    PG8_BAR;
#undef PG8_SA
#undef PG8_SB
#undef PG8_STAGE
#undef PG8_LDA
#undef PG8_LDB
#undef PG8_MMA
#undef PG8_WAIT_V
#undef PG8_WAIT_L
#undef PG8_BAR
#undef PG8_SCHED
}
}

#define XB_TMO      128
#define XB_XCNT(j)  (256  + 64 * (j))
#define XB_XSUB(j)  (1280 + 64 * (j))
#define XB_XGEN(j)  (2304 + 64 * (j))
#define XB_TOP      3328
#define XB_TOPGEN   3392
#define XCD_BAR_WORDS 3456
#define XB_SPIN_CAP (1u << 18)
__device__ __forceinline__ unsigned xb_ld(unsigned* p)              { return __hip_atomic_load(p, __ATOMIC_RELAXED, __HIP_MEMORY_SCOPE_AGENT); }
__device__ __forceinline__ unsigned xb_add(unsigned* p, unsigned v) { return __hip_atomic_fetch_add(p, v, __ATOMIC_RELAXED, __HIP_MEMORY_SCOPE_AGENT); }
__device__ __forceinline__ unsigned xb_xcc_id() { return (unsigned)__builtin_amdgcn_s_getreg((3 << 11) | 20) & 0xFu; }
#define XB_SPIN(cond, bar) do { unsigned _sp = 0; while (cond) { __builtin_amdgcn_s_sleep(1); \
    if ((++_sp & 255u) == 0u) { if (xb_ld(&(bar)[XB_TMO])) break; if (_sp > XB_SPIN_CAP) { atomicAdd(&(bar)[XB_TMO], 1u); break; } } } } while (0)
struct XcdBarrier { unsigned* bar; unsigned x; volatile LAS unsigned* st; };
__device__ __forceinline__ XcdBarrier xcd_barrier_post(unsigned* bar, volatile LAS unsigned* st) {
    XcdBarrier b; b.bar = bar; b.x = xb_xcc_id(); b.st = st;
    if (threadIdx.x == 0) (void)xb_add(&bar[XB_XCNT(b.x)], 1u);
    return b;
}
__device__ __forceinline__ void xcd_barrier_complete(unsigned* bar, unsigned x, unsigned& nloc, unsigned& nx) {
    const unsigned G = gridDim.x * gridDim.y * gridDim.z;
    unsigned sum, cnt, mine, sp = 0u;
    for (;;) {
        sum = 0u; cnt = 0u; mine = 0u;
#pragma unroll
        for (unsigned j = 0; j < 16; ++j) { const unsigned c = xb_ld(&bar[XB_XCNT(j)]); sum += c; cnt += (c > 0u) ? 1u : 0u; mine = (j == x) ? c : mine; }
        if (sum == G) break;
        __builtin_amdgcn_s_sleep(1);
        if ((++sp & 255u) == 0u) { if (xb_ld(&bar[XB_TMO])) break; if (sp > XB_SPIN_CAP) { atomicAdd(&bar[XB_TMO], 1u); break; } }
    }
    nloc = mine > 0u ? mine : 1u; nx = cnt > 0u ? cnt : 1u;
}
__device__ __forceinline__ void xcd_barrier(const XcdBarrier& b) {
    asm volatile("s_waitcnt vmcnt(0)" ::: "memory");
    __syncthreads();
    if (threadIdx.x == 0) {
        unsigned* bar = b.bar;
        __builtin_amdgcn_s_waitcnt(0);
        unsigned nloc = b.st[0], nx = b.st[1];
        if (nloc == 0u) { xcd_barrier_complete(bar, b.x, nloc, nx); b.st[0] = nloc; b.st[1] = nx; }
        const unsigned old = xb_add(&bar[XB_XSUB(b.x)], 1u);
        const unsigned gen = old / nloc;
        if (old + 1u == (gen + 1u) * nloc) {
            __builtin_amdgcn_fence(__ATOMIC_RELEASE, "agent");
            asm volatile("s_waitcnt vmcnt(0)" ::: "memory");
            const unsigned og = xb_add(&bar[XB_TOP], 1u);
            const unsigned tg = og / nx;
            if (og + 1u == (tg + 1u) * nx) xb_add(&bar[XB_TOPGEN], 1u);
            else XB_SPIN(xb_ld(&bar[XB_TOPGEN]) == tg, bar);
            __builtin_amdgcn_fence(__ATOMIC_ACQUIRE, "agent");
            xb_add(&bar[XB_XGEN(b.x)], 1u);
            asm volatile("s_waitcnt vmcnt(0)" ::: "memory");
        } else {
            XB_SPIN(xb_ld(&bar[XB_XGEN(b.x)]) == gen, bar);
            __builtin_amdgcn_fence(__ATOMIC_ACQUIRE, "agent");
            asm volatile("s_waitcnt vmcnt(0)" ::: "memory");
        }
    }
    __syncthreads();
}

constexpr int LDS_STAGE = pg8::STAGE_BYTES;
constexpr int MISC_OFF = LDS_STAGE, LDS_BYTES = LDS_STAGE + 256;

struct Args { const float* in[25]; float* out; unsigned char* ws; int ph_lo, ph_hi; };
typedef const Args __attribute__((address_space(4)))* ArgsP;
#define ARG_IN(i) ((const float*)(const GAS float*)ap->in[i])
#define ARG_OUT ((float*)(GAS float*)ap->out)
#define ARG_WS ((unsigned char*)(GAS unsigned char*)ap->ws)

__device__ __forceinline__ int map_row(int n, int rmap) {
    if (rmap == 1) { const int up = n >= DFF, j = up ? n - DFF : n; return ((j >> 7) << 8) + (up << 7) + (j & 127); }
    if (rmap == 2) { if (n >= 2048) return n; const int gt = n >= 1024, j = gt ? n - 1024 : n; return ((j >> 7) << 8) + (gt << 7) + (j & 127); }
    return n;
}
__device__ __forceinline__ void p0_transpose_item(const float* W, int K, int N, bf16_t* WT, int rmap, const float* gain, LAS float* scr, int item, int lane) {
    const int nblk = N / 32, kb = item / nblk, nb = item % nblk, k0 = 64 * kb, n0 = 32 * nb;
    const int n4 = (lane & 7) * 4;
#pragma unroll
    for (int i = 0; i < 8; ++i) {
        const int kk = i * 8 + (lane >> 3);
        f32x4 v = *(const f32x4*)(W + (size_t)(k0 + kk) * N + n0 + n4);
        if (gain) v = v * gain[k0 + kk];
        LAS float* s = scr + kk * 33 + n4;
        s[0] = v[0]; s[1] = v[1]; s[2] = v[2]; s[3] = v[3];
    }
    LDS_WAIT(); asm volatile("" ::: "memory");
    const int c = lane >> 3;
    const int d0 = map_row(n0, rmap);
#pragma unroll
    for (int j = 0; j < 4; ++j) { const int n = (lane & 7) + 8 * j; const LAS float* s = scr + (8 * c) * 33 + n;
        u32x4 o; o.x = cvt_pk_bf16(s[0 * 33], s[1 * 33]); o.y = cvt_pk_bf16(s[2 * 33], s[3 * 33]); o.z = cvt_pk_bf16(s[4 * 33], s[5 * 33]); o.w = cvt_pk_bf16(s[6 * 33], s[7 * 33]);
        *(u32x4*)(WT + (size_t)(d0 + n) * K + k0 + 8 * c) = o; }
    LDS_WAIT(); asm volatile("" ::: "memory");
}

__device__ __forceinline__ void p0_prologue(ArgsP ap, LAS unsigned char* lds, int tid, int G) {
    const int lane = tid & 63, wave = __builtin_amdgcn_readfirstlane(tid >> 6);
    LAS float* scr = (LAS float*)(lds + wave * 8448);
    const int gw = blockIdx.x * NWAVES + wave, NGW = G * NWAVES;
    unsigned char* ws = ARG_WS;
    constexpr int I_FI = (D / 64) * (2 * DFF / 32), I_FO = (DFF / 64) * (D / 32), I_WI = (D / 64) * (3072 / 32), I_DD = (D / 64) * (D / 32), I_PP = (PLE / 64) * (D / 32), I_PW = (256 / 64) * (256 / 32);
    constexpr int NW_ITEMS = 2 * I_FI + 2 * I_FO + I_WI + 2 * I_DD + I_PP + 4 * I_PW;
    for (int it = gw; it < NW_ITEMS; it += NGW) {
        int r = it;
        if (r < I_FI) { p0_transpose_item(ARG_IN(7), D, 2 * DFF, (bf16_t*)(ws + WS_W1IN), 1, ARG_IN(6), scr, r, lane); continue; } r -= I_FI;
        if (r < I_FI) { p0_transpose_item(ARG_IN(19), D, 2 * DFF, (bf16_t*)(ws + WS_W2IN), 1, ARG_IN(18), scr, r, lane); continue; } r -= I_FI;
        if (r < I_FO) { p0_transpose_item(ARG_IN(8), DFF, D, (bf16_t*)(ws + WS_W1OUT), 0, nullptr, scr, r, lane); continue; } r -= I_FO;
        if (r < I_FO) { p0_transpose_item(ARG_IN(20), DFF, D, (bf16_t*)(ws + WS_W2OUT), 0, nullptr, scr, r, lane); continue; } r -= I_FO;
        if (r < I_WI) { p0_transpose_item(ARG_IN(10), D, 3072, (bf16_t*)(ws + WS_WIN), 2, ARG_IN(9), scr, r, lane); continue; } r -= I_WI;
        if (r < I_DD) { p0_transpose_item(ARG_IN(17), D, D, (bf16_t*)(ws + WS_WOUT), 0, nullptr, scr, r, lane); continue; } r -= I_DD;
        if (r < I_DD) { p0_transpose_item(ARG_IN(22), D, D, (bf16_t*)(ws + WS_WPG), 0, ARG_IN(21), scr, r, lane); continue; } r -= I_DD;
        if (r < I_PP) { p0_transpose_item(ARG_IN(23), PLE, D, (bf16_t*)(ws + WS_WPP), 0, nullptr, scr, r, lane); continue; } r -= I_PP;
        { const int g = r / I_PW; p0_transpose_item(ARG_IN(15) + (size_t)g * 65536, 256, 256, (bf16_t*)(ws + WS_PW) + (size_t)g * 65536, 0, nullptr, scr, r % I_PW, lane); }
    }
    bf16_t* XNB = (bf16_t*)(ws + WS_XNB); bf16_t* PB = (bf16_t*)(ws + WS_PB); float* SS = (float*)(ws + WS_SS);
    for (int r = gw; r < NTOK; r += NGW) {
        const float* xr = r < NPROMPT ? ARG_IN(0) + (size_t)r * D : ARG_IN(1) + (size_t)(r - NPROMPT) * D;
        float sq = 0.f;
#pragma unroll
        for (int j = 0; j < 8; ++j) { const f32x4 v = *(const f32x4*)(xr + 4 * lane + 256 * j);
            sq += (v[0] * v[0] + v[1] * v[1]) + (v[2] * v[2] + v[3] * v[3]);
            u32x2 w; w.x = cvt_pk_bf16(v[0], v[1]); w.y = cvt_pk_bf16(v[2], v[3]);
            *(u32x2*)(XNB + (size_t)r * D + 4 * lane + 256 * j) = w; }
        sq = wave_sum(sq);
        if (lane == 0) SS[r] = sq;
        const float* pr = r < NPROMPT ? ARG_IN(4) + (size_t)r * PLE : ARG_IN(5) + (size_t)(r - NPROMPT) * PLE;
        const f32x4 v = *(const f32x4*)(pr + 4 * lane);
        u32x2 w; w.x = cvt_pk_bf16(v[0], v[1]); w.y = cvt_pk_bf16(v[2], v[3]);
        *(u32x2*)(PB + (size_t)r * PLE + 4 * lane) = w;
    }
    {
        const u32x4 z = {0u, 0u, 0u, 0u};
        const size_t gt = (size_t)blockIdx.x * NTHREADS + tid, GT = (size_t)G * NTHREADS;
        u32x4* p; size_t n;
        p = (u32x4*)(ws + WS_XNB + (size_t)NTOK * D * 2); n = (size_t)(MP - NTOK) * D * 2 / 16; for (size_t i = gt; i < n; i += GT) p[i] = z;
        p = (u32x4*)(ws + WS_ACT + (size_t)NTOK * DFF * 2); n = (size_t)(MP - NTOK) * DFF * 2 / 16; for (size_t i = gt; i < n; i += GT) p[i] = z;
        p = (u32x4*)(ws + WS_MIX + (size_t)NTOK * D * 2); n = (size_t)(MP - NTOK) * D * 2 / 16; for (size_t i = gt; i < n; i += GT) p[i] = z;
        p = (u32x4*)(ws + WS_PB + (size_t)NTOK * PLE * 2); n = (size_t)(MP - NTOK) * PLE * 2 / 16; for (size_t i = gt; i < n; i += GT) p[i] = z;
        p = (u32x4*)(ws + WS_SS + (size_t)MP * 4); n = (size_t)4 * MP * 4 / 16; for (size_t i = gt; i < n; i += GT) p[i] = z;
    }
}

template <int W> __device__ __forceinline__ void pool_d_prompt(const float* U, int b, int t0r, int ch, f32x2 (&d)[4]) {
    f32x2 xr[W + 3];
#pragma unroll
    for (int k = 0; k < W + 3; ++k) { const int t = t0r - (W - 1) + k; xr[k] = t >= 0 ? *(const f32x2*)(U + (size_t)(b * SEQ + t) * PDIM + ch) : (f32x2){0.f, 0.f}; }
#pragma unroll
    for (int tt = 0; tt < 4; ++tt) { f32x2 s = xr[tt];
#pragma unroll
        for (int k = 1; k < W; ++k) s += xr[tt + k];
        const int t = t0r + tt; const float cnt = (float)(t + 1 < W ? t + 1 : W);
        d[tt] = s / cnt - xr[tt + W - 1]; }
}
template <int W> __device__ __forceinline__ void pool_d_sample(const float* U, const float* state, int b0r, int ch, f32x2 (&d)[4]) {
#pragma unroll
    for (int tt = 0; tt < 4; ++tt) { const int b = b0r + tt; const f32x2 uc = *(const f32x2*)(U + (size_t)(NPROMPT + b) * PDIM + ch); f32x2 s = uc;
#pragma unroll
        for (int i = 1; i < W; ++i) s += *(const f32x2*)(state + ((size_t)b * 15 + (15 - i)) * PDIM + ch);
        d[tt] = s / (float)W - uc; }
}

__device__ __forceinline__ void p4_mix(ArgsP ap, LAS unsigned char* lds, int tid, int G) {
    const int lane = tid & 63, wave = __builtin_amdgcn_readfirstlane(tid >> 6);
    unsigned char* ws = ARG_WS;
    const float* V = (const float*)(ws + WS_V); const float* U = (const float*)(ws + WS_U);
    bf16_t* MIX = (bf16_t*)(ws + WS_MIX); const bf16_t* PWT = (const bf16_t*)(ws + WS_PW);
    const float* state_conv = ARG_IN(2); const float* state_pool = ARG_IN(3);
    LAS float* red = (LAS float*)(lds + 16384);
    {
        const int c0 = 2 * tid;
        f32x2 w[31];
#pragma unroll
        for (int j = 0; j < 31; ++j) w[j] = *(const f32x2*)(ARG_IN(11) + (size_t)j * CDIM + c0);
        const f32x2 cb = *(const f32x2*)(ARG_IN(12) + c0), lg = *(const f32x2*)(ARG_IN(13) + c0), lb = *(const f32x2*)(ARG_IN(14) + c0);
        constexpr int NCU = NTOK / 4;
        for (int un = blockIdx.x; un < NCU; un += G) {
            f32x2 o[4];
            const int r0 = 4 * un;
            if (r0 < NPROMPT) {
                const int b = r0 >> 11, t0 = r0 & (SEQ - 1);
                f32x2 x[34];
#pragma unroll
                for (int k = 0; k < 34; ++k) { const int t = t0 - 30 + k; x[k] = t >= 0 ? *(const f32x2*)(V + (size_t)(b * SEQ + t) * CDIM + c0) : (f32x2){0.f, 0.f}; }
#pragma unroll
                for (int tt = 0; tt < 4; ++tt) { f32x2 s = cb;
#pragma unroll
                    for (int j = 0; j < 31; ++j) s += w[j] * x[tt + j];
                    o[tt] = s; }
            } else {
#pragma unroll
                for (int tt = 0; tt < 4; ++tt) { const int b = r0 - NPROMPT + tt; f32x2 s = cb;
#pragma unroll
                    for (int j = 0; j < 30; ++j) s += w[j] * *(const f32x2*)(state_conv + ((size_t)b * 30 + j) * CDIM + c0);
                    s += w[30] * *(const f32x2*)(V + (size_t)(NPROMPT + b) * CDIM + c0);
                    o[tt] = s; }
            }
            float st[8];
#pragma unroll
            for (int tt = 0; tt < 4; ++tt) { st[2 * tt] = wave_sum(o[tt][0] + o[tt][1]); st[2 * tt + 1] = wave_sum(o[tt][0] * o[tt][0] + o[tt][1] * o[tt][1]); }
            if (lane == 0) {
#pragma unroll
                for (int q = 0; q < 8; ++q) red[wave * 8 + q] = st[q]; }
            __syncthreads();
#pragma unroll
            for (int q = 0; q < 8; ++q) { float s = 0.f;
#pragma unroll
                for (int wv = 0; wv < 8; ++wv) s += red[wv * 8 + q];
                st[q] = s; }
            __syncthreads();
#pragma unroll
            for (int tt = 0; tt < 4; ++tt) {
                const float mean = st[2 * tt] * (1.0f / CDIM), var = st[2 * tt + 1] * (1.0f / CDIM) - mean * mean, rstd = __builtin_amdgcn_rsqf(var + EPS);
                const float y0 = (o[tt][0] - mean) * rstd * lg[0] + lb[0], y1 = (o[tt][1] - mean) * rstd * lg[1] + lb[1];
                *(unsigned*)(MIX + (size_t)(r0 + tt) * D + c0) = cvt_pk_bf16(y0 * sigmoidf_fast(y0), y1 * sigmoidf_fast(y1));
            }
        }
    }
    {
        const int cp = tid & 127, rq = __builtin_amdgcn_readfirstlane(tid >> 7), fr = lane & 15, fq = lane >> 4;
        constexpr int NPU = (NTOK / 16) * 4;
        for (int un = blockIdx.x; un < NPU; un += G) {
            const int rt = un >> 2, g = un & 3, r0 = 16 * rt, ch = g * 256 + 2 * cp;
            f32x2 d[4];
            if (r0 < NPROMPT) {
                const int b = r0 >> 11, t0r = (r0 & (SEQ - 1)) + 4 * rq;
                if (g == 0) pool_d_prompt<2>(U, b, t0r, ch, d); else if (g == 1) pool_d_prompt<4>(U, b, t0r, ch, d);
                else if (g == 2) pool_d_prompt<8>(U, b, t0r, ch, d); else pool_d_prompt<16>(U, b, t0r, ch, d);
            } else {
                const int b0r = r0 - NPROMPT + 4 * rq;
                if (g == 0) pool_d_sample<2>(U, state_pool, b0r, ch, d); else if (g == 1) pool_d_sample<4>(U, state_pool, b0r, ch, d);
                else if (g == 2) pool_d_sample<8>(U, state_pool, b0r, ch, d); else pool_d_sample<16>(U, state_pool, b0r, ch, d);
            }
#pragma unroll
            for (int tt = 0; tt < 4; ++tt) *(LAS unsigned*)(lds + (4 * rq + tt) * 528 + 4 * cp) = cvt_pk_bf16(d[tt][0], d[tt][1]);
            __syncthreads();
            f32x4 acc[2] = {{0.f, 0.f, 0.f, 0.f}, {0.f, 0.f, 0.f, 0.f}};
            const bf16_t* wb = PWT + ((size_t)(g * 256 + 32 * wave + fr) * 256 + fq * 8);
#pragma unroll
            for (int ks = 0; ks < 8; ++ks) {
                const bf16x8 af = *(const LAS bf16x8*)(lds + fr * 528 + ks * 64 + fq * 16);
#pragma unroll
                for (int nf = 0; nf < 2; ++nf) { const bf16x8 bfr = *(const bf16x8*)(wb + (size_t)nf * 16 * 256 + ks * 32);
                    acc[nf] = __builtin_amdgcn_mfma_f32_16x16x32_bf16(bfr, af, acc[nf], 0, 0, 0); }
            }
#pragma unroll
            for (int nf = 0; nf < 2; ++nf) { const int cg_ = g * 256 + 32 * wave + nf * 16 + 4 * fq;
                const f32x4 sc = *(const f32x4*)(ARG_IN(16) + cg_); const f32x4 y = acc[nf] * sc;
                u32x2 o; o.x = cvt_pk_bf16(y[0], y[1]); o.y = cvt_pk_bf16(y[2], y[3]);
                *(u32x2*)(MIX + (size_t)(r0 + fr) * D + CDIM + cg_) = o; }
            __syncthreads();
        }
    }
    {
        const int gw = blockIdx.x * NWAVES + wave, NGW = G * NWAVES;
        constexpr int R0 = NBATCH * 30, R1 = R0 + NSAMP * 30, R2 = R1 + NBATCH * 15, R3 = R2 + NSAMP * 15;
        for (int it = gw; it < R3; it += NGW) {
            const float* src; float* dst;
            if (it < R0) { const int b = it / 30, i = it % 30; src = V + (size_t)(b * SEQ + SEQ - 30 + i) * CDIM; dst = ARG_OUT + OUT_NCP + (size_t)it * CDIM; }
            else if (it < R1) { const int q = it - R0, b = q / 30, i = q % 30; src = i < 29 ? state_conv + ((size_t)b * 30 + i + 1) * CDIM : V + (size_t)(NPROMPT + b) * CDIM; dst = ARG_OUT + OUT_NCS + (size_t)q * CDIM; }
            else if (it < R2) { const int q = it - R1, b = q / 15, i = q % 15; src = U + (size_t)(b * SEQ + SEQ - 15 + i) * PDIM; dst = ARG_OUT + OUT_NPP + (size_t)q * PDIM; }
            else { const int q = it - R2, b = q / 15, i = q % 15; src = i < 14 ? state_pool + ((size_t)b * 15 + i + 1) * PDIM : U + (size_t)(NPROMPT + b) * PDIM; dst = ARG_OUT + OUT_NPS + (size_t)q * PDIM; }
#pragma unroll
            for (int j = 0; j < 4; ++j) *(f32x4*)(dst + 4 * lane + 256 * j) = *(const f32x4*)(src + 4 * lane + 256 * j);
        }
    }
}

__device__ __forceinline__ void p9_final(ArgsP ap, int tid, int G) {
    const float* ss = (const float*)(ARG_WS + WS_SS) + (size_t)4 * MP; const float* gn = ARG_IN(24); float* out = ARG_OUT;
    const size_t n4 = (size_t)NTOK * D / 4, GT = (size_t)G * NTHREADS;
    for (size_t i = (size_t)blockIdx.x * NTHREADS + tid; i < n4; i += GT) {
        const int r = (int)(i >> 9), c4 = (int)(i & 511);
        const float rs = __builtin_amdgcn_rsqf(ss[r] * (1.0f / D) + EPS);
        const f32x4 x = *(const f32x4*)(out + i * 4), gg = *(const f32x4*)(gn + 4 * c4);
        *(f32x4*)(out + i * 4) = x * rs * gg;
    }
}

constexpr int N_PHASES = 11;
__global__ void __launch_bounds__(NTHREADS, 2) fwd_kernel(Args args) {
    extern __shared__ __attribute__((aligned(16))) unsigned char lds_raw[];
    LAS unsigned char* lds = (LAS unsigned char*)lds_raw;
    volatile LAS unsigned* MISC = (volatile LAS unsigned*)(lds + MISC_OFF);
    ArgsP ap = (ArgsP)__builtin_amdgcn_kernarg_segment_ptr();
    const int tid = threadIdx.x, G = gridDim.x;
    unsigned char* ws = ARG_WS;
    if (tid < 64) MISC[tid] = 0u;
    __syncthreads();
    const int lo = ap->ph_lo, hi = ap->ph_hi;
    const bool one_launch = (hi - lo) > 1;
    XcdBarrier bar; bar.bar = (unsigned*)(ws + WS_CTL); bar.x = 0; bar.st = nullptr;
    if (one_launch) bar = xcd_barrier_post((unsigned*)(ws + WS_CTL), MISC + 8);
#define IN(k) (lo <= (k) && (k) < hi)
#define SEAM(k) do { if (IN(k) && IN((k) + 1)) xcd_barrier(bar); } while (0)

    float* SS = (float*)(ws + WS_SS);
    bf16_t* XNB = (bf16_t*)(ws + WS_XNB); bf16_t* ACT = (bf16_t*)(ws + WS_ACT); bf16_t* MIX = (bf16_t*)(ws + WS_MIX); bf16_t* PPB = (bf16_t*)(ws + WS_PP); bf16_t* PB = (bf16_t*)(ws + WS_PB);
    float* X = ARG_OUT;

    if (IN(0)) {
        p0_prologue(ap, lds, tid, G);
        if (IN(1)) { if (MK_N_LAUNCHES == 1) { cg::this_grid().sync(); } else xcd_barrier(bar); }
    }
    if (IN(1)) {
        pg8::Gemm g{PB, (const bf16_t*)(ws + WS_WPP), MP, D, PLE}; pg8::StaticOrder S; S.init(MP, D, G, (int)blockIdx.x);
        pg8::Epi<pg8::EP_PP> E{}; E.outb = PPB;
        pg8::gemm_phase(lds, g, S, E);
    }
    if (IN(2)) {
        pg8::Gemm g{XNB, (const bf16_t*)(ws + WS_W1IN), MP, 2 * DFF, D}; pg8::StaticOrder S; S.init(MP, 2 * DFF, G, (int)blockIdx.x);
        pg8::Epi<pg8::EP_SWIGLU> E{}; E.ss_in = SS; E.outb = ACT;
        pg8::gemm_phase(lds, g, S, E);
        SEAM(2);
    }
    if (IN(3)) {
        pg8::Gemm g{ACT, (const bf16_t*)(ws + WS_W1OUT), MP, D, DFF}; pg8::StaticOrder S; S.init(MP, D, G, (int)blockIdx.x);
        pg8::Epi<pg8::EP_RESID> E{}; E.ss_out = SS + MP; E.res0 = ARG_IN(0); E.res1 = ARG_IN(1); E.outf = X; E.outb = XNB; E.scale = 0.5f;
        pg8::gemm_phase(lds, g, S, E);
        SEAM(3);
    }
    if (IN(4)) {
        pg8::Gemm g{XNB, (const bf16_t*)(ws + WS_WIN), MP, 3072, D}; pg8::StaticOrder S; S.init(MP, 3072, G, (int)blockIdx.x);
        pg8::Epi<pg8::EP_WIN> E{}; E.ss_in = SS + MP; E.V = (float*)(ws + WS_V); E.U = (float*)(ws + WS_U);
        pg8::gemm_phase(lds, g, S, E);
        SEAM(4);
    }
    if (IN(5)) {
        p4_mix(ap, lds, tid, G);
        SEAM(5);
    }
    if (IN(6)) {
        pg8::Gemm g{MIX, (const bf16_t*)(ws + WS_WOUT), MP, D, D}; pg8::StaticOrder S; S.init(MP, D, G, (int)blockIdx.x);
        pg8::Epi<pg8::EP_RESID> E{}; E.ss_out = SS + 2 * MP; E.res0 = X; E.res1 = X + (size_t)NPROMPT * D; E.outf = X; E.outb = XNB; E.scale = 1.0f;
        pg8::gemm_phase(lds, g, S, E);
        SEAM(6);
    }
    if (IN(7)) {
        pg8::Gemm g{XNB, (const bf16_t*)(ws + WS_W2IN), MP, 2 * DFF, D}; pg8::StaticOrder S; S.init(MP, 2 * DFF, G, (int)blockIdx.x);
        pg8::Epi<pg8::EP_SWIGLU> E{}; E.ss_in = SS + 2 * MP; E.outb = ACT;
        pg8::gemm_phase(lds, g, S, E);
        SEAM(7);
    }
    if (IN(8)) {
        pg8::Gemm g{ACT, (const bf16_t*)(ws + WS_W2OUT), MP, D, DFF}; pg8::StaticOrder S; S.init(MP, D, G, (int)blockIdx.x);
        pg8::Epi<pg8::EP_RESID> E{}; E.ss_out = SS + 3 * MP; E.res0 = X; E.res1 = X + (size_t)NPROMPT * D; E.outf = X; E.outb = XNB; E.scale = 0.5f;
        pg8::gemm_phase(lds, g, S, E);
        SEAM(8);
    }
    if (IN(9)) {
        pg8::Gemm g{XNB, (const bf16_t*)(ws + WS_WPG), MP, D, D}; pg8::StaticOrder S; S.init(MP, D, G, (int)blockIdx.x);
        pg8::Epi<pg8::EP_PLE> E{}; E.ss_in = SS + 3 * MP; E.ss_out = SS + 4 * MP; E.outf = X; E.pp = PPB;
        pg8::gemm_phase(lds, g, S, E);
        SEAM(9);
    }
    if (IN(10)) p9_final(ap, tid, G);
#undef IN
#undef SEAM
}

extern "C" void kernel_launch(void* const* d_in, const int* in_sizes, int n_in, void* d_out, int out_size, void* d_ws, size_t ws_size, hipStream_t stream) {
    static int grid = 0;
    if (grid == 0) {
        if (n_in != 25 || (size_t)out_size != OUT_END || ws_size < WS_END) {
            fprintf(stderr, "kernel_launch: built for 25 inputs, %zu outputs, >= %zu bytes of workspace; got n_in %d, out %d, ws %zu; nothing launched\n", (size_t)OUT_END, (size_t)WS_END, n_in, out_size, ws_size);
            grid = -1; return; }
        int dev = 0, cus = 0, per_cu = 0;
        if (hipGetDevice(&dev) != hipSuccess || hipDeviceGetAttribute(&cus, hipDeviceAttributeMultiprocessorCount, dev) != hipSuccess) { fprintf(stderr, "kernel_launch: device query failed\n"); grid = -1; return; }
        if (hipFuncSetAttribute((const void*)fwd_kernel, hipFuncAttributeMaxDynamicSharedMemorySize, LDS_BYTES) != hipSuccess) { fprintf(stderr, "kernel_launch: hipFuncSetAttribute failed\n"); grid = -1; return; }
        if (hipOccupancyMaxActiveBlocksPerMultiprocessor(&per_cu, (const void*)fwd_kernel, NTHREADS, LDS_BYTES) != hipSuccess || per_cu < 1) { fprintf(stderr, "kernel_launch: occupancy query says %d blocks per CU\n", per_cu); (void)hipGetLastError(); per_cu = 1; }
        grid = cus * 1;
        fprintf(stderr, "kernel_launch: %d CUs, occupancy query %d block(s)/CU, grid %d, LDS %d B, ws %zu B (need %zu)\n", cus, per_cu, grid, LDS_BYTES, ws_size, (size_t)WS_END);
    }
    if (grid < 0) return;
    if (hipMemsetAsync((char*)d_ws + WS_CTL, 0, CTL_BYTES, stream) != hipSuccess) { fprintf(stderr, "kernel_launch: memset failed\n"); return; }
    Args a{};
    for (int i = 0; i < 25; ++i) a.in[i] = (const float*)d_in[i];
    a.out = (float*)d_out; a.ws = (unsigned char*)d_ws;
#if MK_N_LAUNCHES == 1
    a.ph_lo = 0; a.ph_hi = N_PHASES;
    void* kargs[] = {&a};
    hipError_t e = hipLaunchCooperativeKernel((const void*)fwd_kernel, dim3(grid), dim3(NTHREADS), kargs, LDS_BYTES, stream);
    if (e != hipSuccess) fprintf(stderr, "kernel_launch: cooperative launch failed: %s (grid %d)\n", hipGetErrorString(e), grid);
#else
    for (int ph = 0; ph < N_PHASES; ++ph) {
        a.ph_lo = ph; a.ph_hi = ph + 1;
        hipLaunchKernelGGL(fwd_kernel, dim3(grid), dim3(NTHREADS), LDS_BYTES, stream, a);
        const hipError_t le = hipPeekAtLastError();
        if (le != hipSuccess) { fprintf(stderr, "kernel_launch: launch %d failed: %s\n", ph, hipGetErrorName(le)); break; }
    }
#endif
}
```

```cpp
#include <hip/hip_runtime.h>
#include <hip/hip_cooperative_groups.h>
#include <cstdio>
#include <cstdint>
namespace cg = cooperative_groups;

#ifndef MK_N_LAUNCHES
#define MK_N_LAUNCHES 1
#endif

#define LAS __attribute__((address_space(3)))
#define GAS __attribute__((address_space(1)))
typedef unsigned short bf16_t;
typedef short bf16x8 __attribute__((ext_vector_type(8)));
typedef float f32x4 __attribute__((ext_vector_type(4)));
typedef float f32x2 __attribute__((ext_vector_type(2)));
typedef unsigned u32x4 __attribute__((ext_vector_type(4)));
typedef unsigned u32x2 __attribute__((ext_vector_type(2)));

constexpr int D = 2048, DFF = 5632, NPROMPT = 8192, NSAMP = 128, NTOK = NPROMPT + NSAMP, MP = 8448  , SEQ = 2048;
constexpr int CDIM = 1024, PDIM = 1024, PLE = 256, NBATCH = 4;
constexpr float EPS = 1e-6f;
constexpr int NWAVES = 8, NTHREADS = 512;

constexpr size_t WS_CTL = 0, CTL_BYTES = 65536;
constexpr size_t WS_W1IN = WS_CTL + CTL_BYTES;
constexpr size_t WS_W1OUT = WS_W1IN + (size_t)2 * DFF * D * 2;
constexpr size_t WS_W2IN = WS_W1OUT + (size_t)D * DFF * 2;
constexpr size_t WS_W2OUT = WS_W2IN + (size_t)2 * DFF * D * 2;
constexpr size_t WS_WIN = WS_W2OUT + (size_t)D * DFF * 2;
constexpr size_t WS_WOUT = WS_WIN + (size_t)3072 * D * 2;
constexpr size_t WS_WPG = WS_WOUT + (size_t)D * D * 2;
constexpr size_t WS_WPP = WS_WPG + (size_t)D * D * 2;
constexpr size_t WS_PW = WS_WPP + (size_t)D * PLE * 2;
constexpr size_t WS_XNB = WS_PW + (size_t)4 * 256 * 256 * 2;
constexpr size_t WS_ACT = WS_XNB + (size_t)MP * D * 2;
constexpr size_t WS_V = WS_ACT, WS_U = WS_ACT + (size_t)MP * CDIM * 4;
constexpr size_t WS_MIX = WS_ACT + (size_t)MP * DFF * 2;
constexpr size_t WS_PP = WS_MIX + (size_t)MP * D * 2;
constexpr size_t WS_PB = WS_PP + (size_t)MP * D * 2;
constexpr size_t WS_SS = WS_PB + (size_t)MP * PLE * 2;
constexpr size_t WS_END = WS_SS + (size_t)5 * MP * 4;
static_assert(WS_U + (size_t)MP * PDIM * 4 <= WS_ACT + (size_t)NTOK * DFF * 2, "V/U overlay must not reach the act pad rows");

constexpr size_t OUT_Y = 0, OUT_NCP = (size_t)NTOK * D, OUT_NCS = OUT_NCP + (size_t)NBATCH * 30 * CDIM, OUT_NPP = OUT_NCS + (size_t)NSAMP * 30 * CDIM,
                 OUT_NPS = OUT_NPP + (size_t)NBATCH * 15 * PDIM, OUT_END = OUT_NPS + (size_t)NSAMP * 15 * PDIM;

__device__ __forceinline__ unsigned cvt_pk_bf16(float lo, float hi) { unsigned r; asm volatile("v_cvt_pk_bf16_f32 %0, %1, %2" : "=v"(r) : "v"(lo), "v"(hi)); return r; }
__device__ __forceinline__ float bf_lo(unsigned w) { return __uint_as_float(w << 16); }
__device__ __forceinline__ float bf_hi(unsigned w) { return __uint_as_float(w & 0xffff0000u); }
__device__ __forceinline__ float sigmoidf_fast(float x) { return __builtin_amdgcn_rcpf(1.0f + __builtin_amdgcn_exp2f(-1.44269504089f * x)); }
__device__ __forceinline__ float wave_sum(float v) {
#pragma unroll
    for (int o = 1; o < 64; o <<= 1) v += __shfl_xor(v, o);
    return v;
}
#define LDS_WAIT() asm volatile("s_waitcnt lgkmcnt(0)" ::: "memory")
#define VM_WAIT() asm volatile("s_waitcnt vmcnt(0)" ::: "memory")

namespace pg8 {
constexpr int BM = 256, BK = 64, HALF = 128, HTB = HALF * BK * 2  , STAGE_BYTES = 8 * HTB, NXCD = 8, WGM = 8;
__host__ __device__ __forceinline__ int lds_byte(int r, int c) { const int st = (r >> 4) * 2 + (c >> 5), rr = r & 15, cc = c & 31, ob = rr * 64 + cc * 2; return st * 1024 + (ob ^ (((ob >> 9) & 1) << 5)); }
__host__ __device__ __forceinline__ void stage_rc(int b, int& R, int& C) { const int st = b / 1024, sb = b % 1024, swz = sb ^ (((sb >> 9) & 1) << 5); R = (st >> 1) * 16 + swz / 64; C = (st & 1) * 32 + (swz % 64) / 2; }
__host__ __device__ __forceinline__ int perm32(int rho) { const int n = rho >> 4, i = rho & 15; return 8 * (i >> 2) + 4 * n + (i & 3); }

struct Unit { int pm, pn; };
struct Gemm { const bf16_t* A; const bf16_t* Bt; int M, N, K; };

struct StaticOrder {
    int nM, nN, nwg, G, c;
    __host__ __device__ void init(int M, int N, int G_, int c_) { nM = M / BM; nN = N / BM; nwg = nM * nN; G = G_; c = c_; }
    __host__ __device__ bool next(int i, Unit& u) const {
        const long L = (long)i * G + c; if (L >= nwg) return false;
        int wgid = (int)L; { const int q = nwg / NXCD, r = nwg % NXCD, xcd = wgid % NXCD, off = wgid / NXCD; wgid = (xcd < r ? xcd * (q + 1) : r * (q + 1) + (xcd - r) * q) + off; }
        const int nig = WGM * nN, gid = wgid / nig, fm = gid * WGM, gsz = (nM - fm) < WGM ? (nM - fm) : WGM;
        u.pm = fm + ((wgid % nig) % gsz); u.pn = (wgid % nig) / gsz; return true;
    }
    __device__ __forceinline__ void a_ready(const Unit&) const {}
    __device__ __forceinline__ void done(const Unit&) const {}
};

enum { EP_SWIGLU = 0, EP_RESID = 1, EP_WIN = 2, EP_PP = 3, EP_PLE = 4 };
template <int MODE> struct Epi {
    static constexpr bool PERM = true, AFTER_DRAIN = false;
    const float* ss_in;
    float* ss_out;
    const float* res0;
    const float* res1;
    float* outf;
    bf16_t* outb;
    float* V; float* U;
    const bf16_t* pp;
    float scale;
    __device__ __forceinline__ void operator()(const f32x4 (&acc)[2][2][4][2], const Unit& u, int wr, int wc, int fr, int fq) const {
        const int rowb = u.pm * BM + wr * 64 + fr;
        const int cw = wc * 32 + 8 * fq;
#pragma unroll
        for (int ai = 0; ai < 2; ++ai) {
            if (u.pm * BM + ai * HALF >= NTOK) continue;
#pragma unroll
            for (int m = 0; m < 4; ++m) {
                const int r = rowb + ai * HALF + m * 16;
                float rs = 1.0f;
                if (MODE == EP_SWIGLU || MODE == EP_WIN || MODE == EP_PLE) rs = __builtin_amdgcn_rsqf(ss_in[r] * (1.0f / D) + EPS);
                if (MODE == EP_SWIGLU) {
                    f32x4 a[2];
#pragma unroll
                    for (int n = 0; n < 2; ++n)
#pragma unroll
                        for (int j = 0; j < 4; ++j) { const float g = acc[ai][0][m][n][j] * rs, up = acc[ai][1][m][n][j] * rs; a[n][j] = g * sigmoidf_fast(g) * up; }
                    u32x4 w; w.x = cvt_pk_bf16(a[0][0], a[0][1]); w.y = cvt_pk_bf16(a[0][2], a[0][3]); w.z = cvt_pk_bf16(a[1][0], a[1][1]); w.w = cvt_pk_bf16(a[1][2], a[1][3]);
                    *(u32x4*)(outb + (size_t)r * DFF + u.pn * HALF + cw) = w;
                } else if (MODE == EP_RESID) {
                    const float* rp = (u.pm < NPROMPT / BM ? res0 + (size_t)r * D : res1 + (size_t)(r - NPROMPT) * D) + u.pn * BM + cw;
                    float* op = outf + (size_t)r * D + u.pn * BM + cw; bf16_t* ob = outb + (size_t)r * D + u.pn * BM + cw;
                    float sq = 0.f;
#pragma unroll
                    for (int bj = 0; bj < 2; ++bj) {
                        const f32x4 x0 = *(const f32x4*)(rp + bj * HALF), x1 = *(const f32x4*)(rp + bj * HALF + 4);
                        const f32x4 y0 = x0 + acc[ai][bj][m][0] * scale, y1 = x1 + acc[ai][bj][m][1] * scale;
                        *(f32x4*)(op + bj * HALF) = y0; *(f32x4*)(op + bj * HALF + 4) = y1;
                        u32x4 w; w.x = cvt_pk_bf16(y0[0], y0[1]); w.y = cvt_pk_bf16(y0[2], y0[3]); w.z = cvt_pk_bf16(y1[0], y1[1]); w.w = cvt_pk_bf16(y1[2], y1[3]);
                        *(u32x4*)(ob + bj * HALF) = w;
                        sq += (y0[0] * y0[0] + y0[1] * y0[1]) + (y0[2] * y0[2] + y0[3] * y0[3]) + (y1[0] * y1[0] + y1[1] * y1[1]) + (y1[2] * y1[2] + y1[3] * y1[3]);
                    }
                    sq += __shfl_xor(sq, 16); sq += __shfl_xor(sq, 32);
                    if (fq == 0) unsafeAtomicAdd(ss_out + r, sq);
                } else if (MODE == EP_WIN) {
                    if (u.pn < 8) {
                        float* vp = V + (size_t)r * CDIM + u.pn * HALF + cw;
#pragma unroll
                        for (int n = 0; n < 2; ++n) { f32x4 o;
#pragma unroll
                            for (int j = 0; j < 4; ++j) o[j] = (acc[ai][0][m][n][j] * rs) * sigmoidf_fast(acc[ai][1][m][n][j] * rs);
                            *(f32x4*)(vp + 4 * n) = o; }
                    } else {
                        float* upt = U + (size_t)r * PDIM + (u.pn - 8) * BM + cw;
#pragma unroll
                        for (int bj = 0; bj < 2; ++bj)
#pragma unroll
                            for (int n = 0; n < 2; ++n) *(f32x4*)(upt + bj * HALF + 4 * n) = acc[ai][bj][m][n] * rs;
                    }
                } else if (MODE == EP_PP) {
                    bf16_t* ob = outb + (size_t)r * D + u.pn * BM + cw;
#pragma unroll
                    for (int bj = 0; bj < 2; ++bj) { const f32x4 y0 = acc[ai][bj][m][0], y1 = acc[ai][bj][m][1];
                        u32x4 w; w.x = cvt_pk_bf16(y0[0], y0[1]); w.y = cvt_pk_bf16(y0[2], y0[3]); w.z = cvt_pk_bf16(y1[0], y1[1]); w.w = cvt_pk_bf16(y1[2], y1[3]);
                        *(u32x4*)(ob + bj * HALF) = w; }
                } else {
                    float* op = outf + (size_t)r * D + u.pn * BM + cw; const bf16_t* pb = pp + (size_t)r * D + u.pn * BM + cw;
                    float sq = 0.f;
#pragma unroll
                    for (int bj = 0; bj < 2; ++bj) {
                        const f32x4 x0 = *(const f32x4*)(op + bj * HALF), x1 = *(const f32x4*)(op + bj * HALF + 4);
                        const u32x4 pw = *(const u32x4*)(pb + bj * HALF);
                        const f32x4 p0 = {bf_lo(pw.x), bf_hi(pw.x), bf_lo(pw.y), bf_hi(pw.y)}, p1 = {bf_lo(pw.z), bf_hi(pw.z), bf_lo(pw.w), bf_hi(pw.w)};
                        f32x4 y0, y1;
#pragma unroll
                        for (int j = 0; j < 4; ++j) { y0[j] = x0[j] + sigmoidf_fast(acc[ai][bj][m][0][j] * rs) * p0[j]; y1[j] = x1[j] + sigmoidf_fast(acc[ai][bj][m][1][j] * rs) * p1[j]; }
                        *(f32x4*)(op + bj * HALF) = y0; *(f32x4*)(op + bj * HALF + 4) = y1;
                        sq += (y0[0] * y0[0] + y0[1] * y0[1]) + (y0[2] * y0[2] + y0[3] * y0[3]) + (y1[0] * y1[0] + y1[1] * y1[1]) + (y1[2] * y1[2] + y1[3] * y1[3]);
                    }
                    sq += __shfl_xor(sq, 16); sq += __shfl_xor(sq, 32);
                    if (fq == 0) unsafeAtomicAdd(ss_out + r, sq);
                }
            }
        }
    }
};

template <class Epi, class Sched, bool ALIGN_EPI = true, bool SP2 = true>
__device__ __forceinline__ void gemm_phase(LAS unsigned char* lds, const Gemm g, const Sched& S, const Epi& E) {
    int tid_ = threadIdx.x; asm volatile("" : "+v"(tid_));
    const int tid = tid_, wid = __builtin_amdgcn_readfirstlane(tid >> 6), lane = tid & 63, wr = wid >> 2, wc = wid & 3, fr = lane & 15, fq = lane >> 4;
    const int K = g.K, nt = K / BK;
    unsigned voffA[2], voffB[2];
#pragma unroll
    for (int i = 0; i < 2; ++i) { int R, C; stage_rc(tid * 16 + i * 8192, R, C); const int Rb = Epi::PERM ? ((R & ~31) + perm32(R & 31)) : R;
        voffA[i] = (unsigned)(R * K + C) * 2u; voffB[i] = (unsigned)(Rb * K + C) * 2u; }
    const size_t kstep = (size_t)(BK * 2);
    const size_t hstep = (size_t)HALF * K * 2;
    const size_t tstep = 2 * hstep;
    const unsigned ldsw = (unsigned)wid * 1024u;
    const int aoff = lds_byte(wr * 64 + fr, fq * 8), boff = lds_byte(wc * 32 + fr, fq * 8);
#define PG8_SA(b, h) (((b) * 2 + (h)) * HTB)
#define PG8_SB(b, h) ((4 + (b) * 2 + (h)) * HTB)
#define PG8_STAGE(bufoff, gbase, voff) do { _Pragma("unroll") for (int _i = 0; _i < 2; ++_i) \
        __builtin_amdgcn_global_load_lds((const unsigned*)((const char*)(gbase) + (voff)[_i]), (LAS unsigned*)(lds + (bufoff) + ldsw + _i * 8192), 16, 0, 0); } while (0)
#define PG8_LDA(dst, b, h) do { _Pragma("unroll") for (int m = 0; m < 4; ++m) _Pragma("unroll") for (int k = 0; k < 2; ++k) dst[m][k] = *(const LAS bf16x8*)(lds + PG8_SA(b, h) + aoff + m * 2048 + k * 1024); } while (0)
#define PG8_LDB(dst, b, h) do { _Pragma("unroll") for (int n = 0; n < 2; ++n) _Pragma("unroll") for (int k = 0; k < 2; ++k) dst[n][k] = *(const LAS bf16x8*)(lds + PG8_SB(b, h) + boff + n * 2048 + k * 1024); } while (0)
#define PG8_MMA(ai, bj, At, Bt) do { __builtin_amdgcn_s_setprio(1); _Pragma("unroll") for (int m = 0; m < 4; ++m) _Pragma("unroll") for (int n = 0; n < 2; ++n) _Pragma("unroll") for (int k = 0; k < 2; ++k) \
        acc[ai][bj][m][n] = __builtin_amdgcn_mfma_f32_16x16x32_bf16(Bt[n][k], At[m][k], acc[ai][bj][m][n], 0, 0, 0); __builtin_amdgcn_s_setprio(0); } while (0)
#define PG8_WAIT_V(n) asm volatile("s_waitcnt vmcnt(" #n ")" ::: "memory")
#define PG8_WAIT_L(n) asm volatile("s_waitcnt lgkmcnt(" #n ")" ::: "memory")
#define PG8_BAR __builtin_amdgcn_s_barrier()
#define PG8_SCHED __builtin_amdgcn_sched_barrier(0)
    Unit cur, nxt; int ui = 0;
    if (!S.next(0, cur)) return;
    f32x4 acc[2][2][4][2];
#pragma unroll
    for (int a = 0; a < 2; ++a)
#pragma unroll
        for (int b = 0; b < 2; ++b)
#pragma unroll
            for (int m = 0; m < 4; ++m)
#pragma unroll
                for (int n = 0; n < 2; ++n) acc[a][b][m][n] = (f32x4){0.f, 0.f, 0.f, 0.f};
    bf16x8 At[4][2], B0[2][2], B1[2][2];
    const char* cA = (const char*)g.A + (size_t)cur.pm * tstep; const char* cB = (const char*)g.Bt + (size_t)cur.pn * tstep;
    S.a_ready(cur);
    if constexpr (SP2) {
        PG8_STAGE(PG8_SB(0, 0), cB, voffB); PG8_STAGE(PG8_SB(0, 1), cB + hstep, voffB); PG8_STAGE(PG8_SA(0, 0), cA, voffA); PG8_STAGE(PG8_SA(0, 1), cA + hstep, voffA);
        if (wr == 1) PG8_BAR;
        PG8_WAIT_V(2); PG8_BAR;
        PG8_STAGE(PG8_SB(1, 0), cB + kstep, voffB); PG8_STAGE(PG8_SA(1, 0), cA + kstep, voffA); PG8_STAGE(PG8_SB(1, 1), cB + hstep + kstep, voffB);
        PG8_WAIT_V(6); PG8_BAR;
    } else {
        PG8_STAGE(PG8_SB(0, 0), cB, voffB); PG8_STAGE(PG8_SA(0, 0), cA, voffA); PG8_STAGE(PG8_SB(0, 1), cB + hstep, voffB); PG8_STAGE(PG8_SA(0, 1), cA + hstep, voffA);
        if (wr == 1) PG8_BAR;
        PG8_WAIT_V(4); PG8_BAR;
        PG8_STAGE(PG8_SB(1, 0), cB + kstep, voffB); PG8_STAGE(PG8_SA(1, 0), cA + kstep, voffA); PG8_STAGE(PG8_SB(1, 1), cB + hstep + kstep, voffB);
        PG8_WAIT_V(6); PG8_BAR;
    }
    for (;;) {
        const bool has_next = S.next(ui + 1, nxt);
        const char* nA = has_next ? (const char*)g.A + (size_t)nxt.pm * tstep : cA; const char* nB = has_next ? (const char*)g.Bt + (size_t)nxt.pn * tstep : cB;
#pragma nounroll
        for (int t = 0; t < nt; t += 2) {
            const bool last = (t == nt - 2);
            const char* a1 = cA + (size_t)(t + 1) * kstep;
            const char* a2 = last ? nA : cA + (size_t)(t + 2) * kstep; const char* b2 = last ? nB : cB + (size_t)(t + 2) * kstep;
            const char* a3 = a2 + kstep; const char* b3 = b2 + kstep;
            if (last && has_next) S.a_ready(nxt);
            if constexpr (SP2) {
            PG8_LDB(B0, 0, 0); PG8_LDB(B1, 0, 1); PG8_SCHED; PG8_LDA(At, 0, 0); PG8_STAGE(PG8_SA(1, 1), a1 + hstep, voffA);
            PG8_WAIT_V(8); PG8_WAIT_L(0); PG8_BAR; PG8_MMA(0, 0, At, B0); PG8_MMA(0, 1, At, B1); PG8_BAR; PG8_SCHED;
            PG8_LDA(At, 0, 1); PG8_STAGE(PG8_SB(0, 0), b2, voffB); PG8_STAGE(PG8_SB(0, 1), b2 + hstep, voffB); PG8_STAGE(PG8_SA(0, 0), a2, voffA);
            PG8_WAIT_V(8); PG8_WAIT_L(0); PG8_BAR; PG8_MMA(1, 0, At, B0); PG8_MMA(1, 1, At, B1); PG8_BAR; PG8_SCHED;
            PG8_LDB(B0, 1, 0); PG8_LDB(B1, 1, 1); PG8_SCHED; PG8_LDA(At, 1, 0); PG8_STAGE(PG8_SA(0, 1), a2 + hstep, voffA);
            PG8_WAIT_V(8); PG8_WAIT_L(0); PG8_BAR; PG8_MMA(0, 0, At, B0); PG8_MMA(0, 1, At, B1); PG8_BAR; PG8_SCHED;
            PG8_LDA(At, 1, 1); PG8_STAGE(PG8_SB(1, 0), b3, voffB); PG8_STAGE(PG8_SB(1, 1), b3 + hstep, voffB); PG8_STAGE(PG8_SA(1, 0), a3, voffA);
            PG8_WAIT_V(8); PG8_WAIT_L(0); PG8_BAR; PG8_MMA(1, 0, At, B0); PG8_MMA(1, 1, At, B1); PG8_BAR; PG8_SCHED;
            } else {
            PG8_LDB(B0, 0, 0); PG8_SCHED; PG8_LDA(At, 0, 0); PG8_STAGE(PG8_SA(1, 1), a1 + hstep, voffA);
            PG8_WAIT_L(8); PG8_BAR; PG8_WAIT_L(0); PG8_MMA(0, 0, At, B0); PG8_BAR; PG8_SCHED;
            PG8_LDB(B1, 0, 1); PG8_STAGE(PG8_SB(0, 0), b2, voffB);
            PG8_BAR; PG8_WAIT_L(0); PG8_MMA(0, 1, At, B1); PG8_BAR;
            PG8_LDA(At, 0, 1); PG8_STAGE(PG8_SA(0, 0), a2, voffA);
            PG8_BAR; PG8_WAIT_L(0); PG8_MMA(1, 0, At, B0); PG8_BAR; PG8_SCHED;
            PG8_STAGE(PG8_SB(0, 1), b2 + hstep, voffB);
            PG8_WAIT_V(6); PG8_BAR; PG8_MMA(1, 1, At, B1); PG8_BAR;
            PG8_LDB(B0, 1, 0); PG8_SCHED; PG8_LDA(At, 1, 0); PG8_STAGE(PG8_SA(0, 1), a2 + hstep, voffA);
            PG8_WAIT_L(8); PG8_BAR; PG8_WAIT_L(0); PG8_MMA(0, 0, At, B0); PG8_BAR; PG8_SCHED;
            PG8_LDB(B1, 1, 1); PG8_STAGE(PG8_SB(1, 0), b3, voffB);
            PG8_BAR; PG8_WAIT_L(0); PG8_MMA(0, 1, At, B1); PG8_BAR;
            PG8_LDA(At, 1, 1); PG8_STAGE(PG8_SA(1, 0), a3, voffA);
            PG8_BAR; PG8_WAIT_L(0); PG8_MMA(1, 0, At, B0); PG8_BAR; PG8_SCHED;
            PG8_STAGE(PG8_SB(1, 1), b3 + hstep, voffB);
            PG8_WAIT_V(6); PG8_BAR; PG8_MMA(1, 1, At, B1); PG8_BAR;
            }
        }
        if constexpr (ALIGN_EPI) { if (wr == 0) PG8_BAR; }
        if constexpr (!Epi::AFTER_DRAIN) { E(acc, cur, wr, wc, fr, fq); S.done(cur); }
        if (!has_next) break;
#pragma unroll
        for (int a = 0; a < 2; ++a)
#pragma unroll
            for (int b = 0; b < 2; ++b)
#pragma unroll
                for (int m = 0; m < 4; ++m)
#pragma unroll
                    for (int n = 0; n < 2; ++n) acc[a][b][m][n] = (f32x4){0.f, 0.f, 0.f, 0.f};
        cur = nxt; cA = nA; cB = nB; ++ui;
        if constexpr (ALIGN_EPI) { if (wr == 1) PG8_BAR; }
    }
    PG8_WAIT_V(0);
    if constexpr (!ALIGN_EPI) { if (wr == 0) PG8_BAR; }
    PG8_BAR;
#undef PG8_SA
#undef PG8_SB
#undef PG8_STAGE
#undef PG8_LDA
#undef PG8_LDB
#undef PG8_MMA
#undef PG8_WAIT_V
#undef PG8_WAIT_L
#undef PG8_BAR
#undef PG8_SCHED
}
}

#define XB_TMO      128
#define XB_XCNT(j)  (256  + 64 * (j))
#define XB_XSUB(j)  (1280 + 64 * (j))
#define XB_XGEN(j)  (2304 + 64 * (j))
#define XB_TOP      3328
#define XB_TOPGEN   3392
#define XCD_BAR_WORDS 3456
#define XB_SPIN_CAP (1u << 18)
__device__ __forceinline__ unsigned xb_ld(unsigned* p)              { return __hip_atomic_load(p, __ATOMIC_RELAXED, __HIP_MEMORY_SCOPE_AGENT); }
__device__ __forceinline__ unsigned xb_add(unsigned* p, unsigned v) { return __hip_atomic_fetch_add(p, v, __ATOMIC_RELAXED, __HIP_MEMORY_SCOPE_AGENT); }
__device__ __forceinline__ unsigned xb_xcc_id() { return (unsigned)__builtin_amdgcn_s_getreg((3 << 11) | 20) & 0xFu; }
#define XB_SPIN(cond, bar) do { unsigned _sp = 0; while (cond) { __builtin_amdgcn_s_sleep(1); \
    if ((++_sp & 255u) == 0u) { if (xb_ld(&(bar)[XB_TMO])) break; if (_sp > XB_SPIN_CAP) { atomicAdd(&(bar)[XB_TMO], 1u); break; } } } } while (0)
struct XcdBarrier { unsigned* bar; unsigned x; volatile LAS unsigned* st; };
__device__ __forceinline__ XcdBarrier xcd_barrier_post(unsigned* bar, volatile LAS unsigned* st) {
    XcdBarrier b; b.bar = bar; b.x = xb_xcc_id(); b.st = st;
    if (threadIdx.x == 0) (void)xb_add(&bar[XB_XCNT(b.x)], 1u);
    return b;
}
__device__ __forceinline__ void xcd_barrier_complete(unsigned* bar, unsigned x, unsigned& nloc, unsigned& nx) {
    const unsigned G = gridDim.x * gridDim.y * gridDim.z;
    unsigned sum, cnt, mine, sp = 0u;
    for (;;) {
        sum = 0u; cnt = 0u; mine = 0u;
#pragma unroll
        for (unsigned j = 0; j < 16; ++j) { const unsigned c = xb_ld(&bar[XB_XCNT(j)]); sum += c; cnt += (c > 0u) ? 1u : 0u; mine = (j == x) ? c : mine; }
        if (sum == G) break;
        __builtin_amdgcn_s_sleep(1);
        if ((++sp & 255u) == 0u) { if (xb_ld(&bar[XB_TMO])) break; if (sp > XB_SPIN_CAP) { atomicAdd(&bar[XB_TMO], 1u); break; } }
    }
    nloc = mine > 0u ? mine : 1u; nx = cnt > 0u ? cnt : 1u;
}
__device__ __forceinline__ void xcd_barrier(const XcdBarrier& b) {
    asm volatile("s_waitcnt vmcnt(0)" ::: "memory");
    __syncthreads();
    if (threadIdx.x == 0) {
        unsigned* bar = b.bar;
        __builtin_amdgcn_s_waitcnt(0);
        unsigned nloc = b.st[0], nx = b.st[1];
        if (nloc == 0u) { xcd_barrier_complete(bar, b.x, nloc, nx); b.st[0] = nloc; b.st[1] = nx; }
        const unsigned old = xb_add(&bar[XB_XSUB(b.x)], 1u);
        const unsigned gen = old / nloc;
        if (old + 1u == (gen + 1u) * nloc) {
            __builtin_amdgcn_fence(__ATOMIC_RELEASE, "agent");
            asm volatile("s_waitcnt vmcnt(0)" ::: "memory");
            const unsigned og = xb_add(&bar[XB_TOP], 1u);
            const unsigned tg = og / nx;
            if (og + 1u == (tg + 1u) * nx) xb_add(&bar[XB_TOPGEN], 1u);
            else XB_SPIN(xb_ld(&bar[XB_TOPGEN]) == tg, bar);
            __builtin_amdgcn_fence(__ATOMIC_ACQUIRE, "agent");
            xb_add(&bar[XB_XGEN(b.x)], 1u);
            asm volatile("s_waitcnt vmcnt(0)" ::: "memory");
        } else {
            XB_SPIN(xb_ld(&bar[XB_XGEN(b.x)]) == gen, bar);
            __builtin_amdgcn_fence(__ATOMIC_ACQUIRE, "agent");
            asm volatile("s_waitcnt vmcnt(0)" ::: "memory");
        }
    }
    __syncthreads();
}

constexpr int LDS_STAGE = pg8::STAGE_BYTES;
constexpr int MISC_OFF = LDS_STAGE, LDS_BYTES = LDS_STAGE + 256;

struct Args { const float* in[25]; float* out; unsigned char* ws; int ph_lo, ph_hi; };
typedef const Args __attribute__((address_space(4)))* ArgsP;
#define ARG_IN(i) ((const float*)(const GAS float*)ap->in[i])
#define ARG_OUT ((float*)(GAS float*)ap->out)
#define ARG_WS ((unsigned char*)(GAS unsigned char*)ap->ws)

__device__ __forceinline__ int map_row(int n, int rmap) {
    if (rmap == 1) { const int up = n >= DFF, j = up ? n - DFF : n; return ((j >> 7) << 8) + (up << 7) + (j & 127); }
    if (rmap == 2) { if (n >= 2048) return n; const int gt = n >= 1024, j = gt ? n - 1024 : n; return ((j >> 7) << 8) + (gt << 7) + (j & 127); }
    return n;
}
__device__ __forceinline__ void p0_transpose_item(const float* W, int K, int N, bf16_t* WT, int rmap, const float* gain, LAS float* scr, int item, int lane) {
    const int nblk = N / 32, kb = item / nblk, nb = item % nblk, k0 = 64 * kb, n0 = 32 * nb;
    const int n4 = (lane & 7) * 4;
#pragma unroll
    for (int i = 0; i < 8; ++i) {
        const int kk = i * 8 + (lane >> 3);
        f32x4 v = *(const f32x4*)(W + (size_t)(k0 + kk) * N + n0 + n4);
        if (gain) v = v * gain[k0 + kk];
        LAS float* s = scr + kk * 33 + n4;
        s[0] = v[0]; s[1] = v[1]; s[2] = v[2]; s[3] = v[3];
    }
    LDS_WAIT(); asm volatile("" ::: "memory");
    const int c = lane >> 3;
    const int d0 = map_row(n0, rmap);
#pragma unroll
    for (int j = 0; j < 4; ++j) { const int n = (lane & 7) + 8 * j; const LAS float* s = scr + (8 * c) * 33 + n;
        u32x4 o; o.x = cvt_pk_bf16(s[0 * 33], s[1 * 33]); o.y = cvt_pk_bf16(s[2 * 33], s[3 * 33]); o.z = cvt_pk_bf16(s[4 * 33], s[5 * 33]); o.w = cvt_pk_bf16(s[6 * 33], s[7 * 33]);
        *(u32x4*)(WT + (size_t)(d0 + n) * K + k0 + 8 * c) = o; }
    LDS_WAIT(); asm volatile("" ::: "memory");
}

__device__ __forceinline__ void p0_prologue(ArgsP ap, LAS unsigned char* lds, int tid, int G) {
    const int lane = tid & 63, wave = __builtin_amdgcn_readfirstlane(tid >> 6);
    LAS float* scr = (LAS float*)(lds + wave * 8448);
    const int gw = blockIdx.x * NWAVES + wave, NGW = G * NWAVES;
    unsigned char* ws = ARG_WS;
    constexpr int I_FI = (D / 64) * (2 * DFF / 32), I_FO = (DFF / 64) * (D / 32), I_WI = (D / 64) * (3072 / 32), I_DD = (D / 64) * (D / 32), I_PP = (PLE / 64) * (D / 32), I_PW = (256 / 64) * (256 / 32);
    constexpr int NW_ITEMS = 2 * I_FI + 2 * I_FO + I_WI + 2 * I_DD + I_PP + 4 * I_PW;
    for (int it = gw; it < NW_ITEMS; it += NGW) {
        int r = it;
        if (r < I_FI) { p0_transpose_item(ARG_IN(7), D, 2 * DFF, (bf16_t*)(ws + WS_W1IN), 1, ARG_IN(6), scr, r, lane); continue; } r -= I_FI;
        if (r < I_FI) { p0_transpose_item(ARG_IN(19), D, 2 * DFF, (bf16_t*)(ws + WS_W2IN), 1, ARG_IN(18), scr, r, lane); continue; } r -= I_FI;
        if (r < I_FO) { p0_transpose_item(ARG_IN(8), DFF, D, (bf16_t*)(ws + WS_W1OUT), 0, nullptr, scr, r, lane); continue; } r -= I_FO;
        if (r < I_FO) { p0_transpose_item(ARG_IN(20), DFF, D, (bf16_t*)(ws + WS_W2OUT), 0, nullptr, scr, r, lane); continue; } r -= I_FO;
        if (r < I_WI) { p0_transpose_item(ARG_IN(10), D, 3072, (bf16_t*)(ws + WS_WIN), 2, ARG_IN(9), scr, r, lane); continue; } r -= I_WI;
        if (r < I_DD) { p0_transpose_item(ARG_IN(17), D, D, (bf16_t*)(ws + WS_WOUT), 0, nullptr, scr, r, lane); continue; } r -= I_DD;
        if (r < I_DD) { p0_transpose_item(ARG_IN(22), D, D, (bf16_t*)(ws + WS_WPG), 0, ARG_IN(21), scr, r, lane); continue; } r -= I_DD;
        if (r < I_PP) { p0_transpose_item(ARG_IN(23), PLE, D, (bf16_t*)(ws + WS_WPP), 0, nullptr, scr, r, lane); continue; } r -= I_PP;
        { const int g = r / I_PW; p0_transpose_item(ARG_IN(15) + (size_t)g * 65536, 256, 256, (bf16_t*)(ws + WS_PW) + (size_t)g * 65536, 0, nullptr, scr, r % I_PW, lane); }
    }
    bf16_t* XNB = (bf16_t*)(ws + WS_XNB); bf16_t* PB = (bf16_t*)(ws + WS_PB); float* SS = (float*)(ws + WS_SS);
    for (int r = gw; r < NTOK; r += NGW) {
        const float* xr = r < NPROMPT ? ARG_IN(0) + (size_t)r * D : ARG_IN(1) + (size_t)(r - NPROMPT) * D;
        float sq = 0.f;
#pragma unroll
        for (int j = 0; j < 8; ++j) { const f32x4 v = *(const f32x4*)(xr + 4 * lane + 256 * j);
            sq += (v[0] * v[0] + v[1] * v[1]) + (v[2] * v[2] + v[3] * v[3]);
            u32x2 w; w.x = cvt_pk_bf16(v[0], v[1]); w.y = cvt_pk_bf16(v[2], v[3]);
            *(u32x2*)(XNB + (size_t)r * D + 4 * lane + 256 * j) = w; }
        sq = wave_sum(sq);
        if (lane == 0) SS[r] = sq;
        const float* pr = r < NPROMPT ? ARG_IN(4) + (size_t)r * PLE : ARG_IN(5) + (size_t)(r - NPROMPT) * PLE;
        const f32x4 v = *(const f32x4*)(pr + 4 * lane);
        u32x2 w; w.x = cvt_pk_bf16(v[0], v[1]); w.y = cvt_pk_bf16(v[2], v[3]);
        *(u32x2*)(PB + (size_t)r * PLE + 4 * lane) = w;
    }
    {
        const u32x4 z = {0u, 0u, 0u, 0u};
        const size_t gt = (size_t)blockIdx.x * NTHREADS + tid, GT = (size_t)G * NTHREADS;
        u32x4* p; size_t n;
        p = (u32x4*)(ws + WS_XNB + (size_t)NTOK * D * 2); n = (size_t)(MP - NTOK) * D * 2 / 16; for (size_t i = gt; i < n; i += GT) p[i] = z;
        p = (u32x4*)(ws + WS_ACT + (size_t)NTOK * DFF * 2); n = (size_t)(MP - NTOK) * DFF * 2 / 16; for (size_t i = gt; i < n; i += GT) p[i] = z;
        p = (u32x4*)(ws + WS_MIX + (size_t)NTOK * D * 2); n = (size_t)(MP - NTOK) * D * 2 / 16; for (size_t i = gt; i < n; i += GT) p[i] = z;
        p = (u32x4*)(ws + WS_PB + (size_t)NTOK * PLE * 2); n = (size_t)(MP - NTOK) * PLE * 2 / 16; for (size_t i = gt; i < n; i += GT) p[i] = z;
        p = (u32x4*)(ws + WS_SS + (size_t)MP * 4); n = (size_t)4 * MP * 4 / 16; for (size_t i = gt; i < n; i += GT) p[i] = z;
    }
}

template <int W> __device__ __forceinline__ void pool_d_prompt(const float* U, int b, int t0r, int ch, f32x2 (&d)[4]) {
    f32x2 xr[W + 3];
#pragma unroll
    for (int k = 0; k < W + 3; ++k) { const int t = t0r - (W - 1) + k; xr[k] = t >= 0 ? *(const f32x2*)(U + (size_t)(b * SEQ + t) * PDIM + ch) : (f32x2){0.f, 0.f}; }
#pragma unroll
    for (int tt = 0; tt < 4; ++tt) { f32x2 s = xr[tt];
#pragma unroll
        for (int k = 1; k < W; ++k) s += xr[tt + k];
        const int t = t0r + tt; const float cnt = (float)(t + 1 < W ? t + 1 : W);
        d[tt] = s / cnt - xr[tt + W - 1]; }
}
template <int W> __device__ __forceinline__ void pool_d_sample(const float* U, const float* state, int b0r, int ch, f32x2 (&d)[4]) {
#pragma unroll
    for (int tt = 0; tt < 4; ++tt) { const int b = b0r + tt; const f32x2 uc = *(const f32x2*)(U + (size_t)(NPROMPT + b) * PDIM + ch); f32x2 s = uc;
#pragma unroll
        for (int i = 1; i < W; ++i) s += *(const f32x2*)(state + ((size_t)b * 15 + (15 - i)) * PDIM + ch);
        d[tt] = s / (float)W - uc; }
}

__device__ __forceinline__ void p4_mix(ArgsP ap, LAS unsigned char* lds, int tid, int G) {
    const int lane = tid & 63, wave = __builtin_amdgcn_readfirstlane(tid >> 6);
    unsigned char* ws = ARG_WS;
    const float* V = (const float*)(ws + WS_V); const float* U = (const float*)(ws + WS_U);
    bf16_t* MIX = (bf16_t*)(ws + WS_MIX); const bf16_t* PWT = (const bf16_t*)(ws + WS_PW);
    const float* state_conv = ARG_IN(2); const float* state_pool = ARG_IN(3);
    LAS float* red = (LAS float*)(lds + 16384);
    {
        const int c0 = 2 * tid;
        f32x2 w[31];
#pragma unroll
        for (int j = 0; j < 31; ++j) w[j] = *(const f32x2*)(ARG_IN(11) + (size_t)j * CDIM + c0);
        const f32x2 cb = *(const f32x2*)(ARG_IN(12) + c0), lg = *(const f32x2*)(ARG_IN(13) + c0), lb = *(const f32x2*)(ARG_IN(14) + c0);
        constexpr int NCU = NTOK / 4;
        for (int un = blockIdx.x; un < NCU; un += G) {
            f32x2 o[4];
            const int r0 = 4 * un;
            if (r0 < NPROMPT) {
                const int b = r0 >> 11, t0 = r0 & (SEQ - 1);
                f32x2 x[34];
#pragma unroll
                for (int k = 0; k < 34; ++k) { const int t = t0 - 30 + k; x[k] = t >= 0 ? *(const f32x2*)(V + (size_t)(b * SEQ + t) * CDIM + c0) : (f32x2){0.f, 0.f}; }
#pragma unroll
                for (int tt = 0; tt < 4; ++tt) { f32x2 s = cb;
#pragma unroll
                    for (int j = 0; j < 31; ++j) s += w[j] * x[tt + j];
                    o[tt] = s; }
            } else {
#pragma unroll
                for (int tt = 0; tt < 4; ++tt) { const int b = r0 - NPROMPT + tt; f32x2 s = cb;
#pragma unroll
                    for (int j = 0; j < 30; ++j) s += w[j] * *(const f32x2*)(state_conv + ((size_t)b * 30 + j) * CDIM + c0);
                    s += w[30] * *(const f32x2*)(V + (size_t)(NPROMPT + b) * CDIM + c0);
                    o[tt] = s; }
            }
            float st[8];
#pragma unroll
            for (int tt = 0; tt < 4; ++tt) { st[2 * tt] = wave_sum(o[tt][0] + o[tt][1]); st[2 * tt + 1] = wave_sum(o[tt][0] * o[tt][0] + o[tt][1] * o[tt][1]); }
            if (lane == 0) {
#pragma unroll
                for (int q = 0; q < 8; ++q) red[wave * 8 + q] = st[q]; }
            __syncthreads();
#pragma unroll
            for (int q = 0; q < 8; ++q) { float s = 0.f;
#pragma unroll
                for (int wv = 0; wv < 8; ++wv) s += red[wv * 8 + q];
                st[q] = s; }
            __syncthreads();
#pragma unroll
            for (int tt = 0; tt < 4; ++tt) {
                const float mean = st[2 * tt] * (1.0f / CDIM), var = st[2 * tt + 1] * (1.0f / CDIM) - mean * mean, rstd = __builtin_amdgcn_rsqf(var + EPS);
                const float y0 = (o[tt][0] - mean) * rstd * lg[0] + lb[0], y1 = (o[tt][1] - mean) * rstd * lg[1] + lb[1];
                *(unsigned*)(MIX + (size_t)(r0 + tt) * D + c0) = cvt_pk_bf16(y0 * sigmoidf_fast(y0), y1 * sigmoidf_fast(y1));
            }
        }
    }
    {
        const int cp = tid & 127, rq = __builtin_amdgcn_readfirstlane(tid >> 7), fr = lane & 15, fq = lane >> 4;
        constexpr int NPU = (NTOK / 16) * 4;
        for (int un = blockIdx.x; un < NPU; un += G) {
            const int rt = un >> 2, g = un & 3, r0 = 16 * rt, ch = g * 256 + 2 * cp;
            f32x2 d[4];
            if (r0 < NPROMPT) {
                const int b = r0 >> 11, t0r = (r0 & (SEQ - 1)) + 4 * rq;
                if (g == 0) pool_d_prompt<2>(U, b, t0r, ch, d); else if (g == 1) pool_d_prompt<4>(U, b, t0r, ch, d);
                else if (g == 2) pool_d_prompt<8>(U, b, t0r, ch, d); else pool_d_prompt<16>(U, b, t0r, ch, d);
            } else {
                const int b0r = r0 - NPROMPT + 4 * rq;
                if (g == 0) pool_d_sample<2>(U, state_pool, b0r, ch, d); else if (g == 1) pool_d_sample<4>(U, state_pool, b0r, ch, d);
                else if (g == 2) pool_d_sample<8>(U, state_pool, b0r, ch, d); else pool_d_sample<16>(U, state_pool, b0r, ch, d);
            }
#pragma unroll
            for (int tt = 0; tt < 4; ++tt) *(LAS unsigned*)(lds + (4 * rq + tt) * 528 + 4 * cp) = cvt_pk_bf16(d[tt][0], d[tt][1]);
            __syncthreads();
            f32x4 acc[2] = {{0.f, 0.f, 0.f, 0.f}, {0.f, 0.f, 0.f, 0.f}};
            const bf16_t* wb = PWT + ((size_t)(g * 256 + 32 * wave + fr) * 256 + fq * 8);
#pragma unroll
            for (int ks = 0; ks < 8; ++ks) {
                const bf16x8 af = *(const LAS bf16x8*)(lds + fr * 528 + ks * 64 + fq * 16);
#pragma unroll
                for (int nf = 0; nf < 2; ++nf) { const bf16x8 bfr = *(const bf16x8*)(wb + (size_t)nf * 16 * 256 + ks * 32);
                    acc[nf] = __builtin_amdgcn_mfma_f32_16x16x32_bf16(bfr, af, acc[nf], 0, 0, 0); }
            }
#pragma unroll
            for (int nf = 0; nf < 2; ++nf) { const int cg_ = g * 256 + 32 * wave + nf * 16 + 4 * fq;
                const f32x4 sc = *(const f32x4*)(ARG_IN(16) + cg_); const f32x4 y = acc[nf] * sc;
                u32x2 o; o.x = cvt_pk_bf16(y[0], y[1]); o.y = cvt_pk_bf16(y[2], y[3]);
                *(u32x2*)(MIX + (size_t)(r0 + fr) * D + CDIM + cg_) = o; }
            __syncthreads();
        }
    }
    {
        const int gw = blockIdx.x * NWAVES + wave, NGW = G * NWAVES;
        constexpr int R0 = NBATCH * 30, R1 = R0 + NSAMP * 30, R2 = R1 + NBATCH * 15, R3 = R2 + NSAMP * 15;
        for (int it = gw; it < R3; it += NGW) {
            const float* src; float* dst;
            if (it < R0) { const int b = it / 30, i = it % 30; src = V + (size_t)(b * SEQ + SEQ - 30 + i) * CDIM; dst = ARG_OUT + OUT_NCP + (size_t)it * CDIM; }
            else if (it < R1) { const int q = it - R0, b = q / 30, i = q % 30; src = i < 29 ? state_conv + ((size_t)b * 30 + i + 1) * CDIM : V + (size_t)(NPROMPT + b) * CDIM; dst = ARG_OUT + OUT_NCS + (size_t)q * CDIM; }
            else if (it < R2) { const int q = it - R1, b = q / 15, i = q % 15; src = U + (size_t)(b * SEQ + SEQ - 15 + i) * PDIM; dst = ARG_OUT + OUT_NPP + (size_t)q * PDIM; }
            else { const int q = it - R2, b = q / 15, i = q % 15; src = i < 14 ? state_pool + ((size_t)b * 15 + i + 1) * PDIM : U + (size_t)(NPROMPT + b) * PDIM; dst = ARG_OUT + OUT_NPS + (size_t)q * PDIM; }
#pragma unroll
            for (int j = 0; j < 4; ++j) *(f32x4*)(dst + 4 * lane + 256 * j) = *(const f32x4*)(src + 4 * lane + 256 * j);
        }
    }
}

__device__ __forceinline__ void p9_final(ArgsP ap, int tid, int G) {
    const float* ss = (const float*)(ARG_WS + WS_SS) + (size_t)4 * MP; const float* gn = ARG_IN(24); float* out = ARG_OUT;
    const size_t n4 = (size_t)NTOK * D / 4, GT = (size_t)G * NTHREADS;
    for (size_t i = (size_t)blockIdx.x * NTHREADS + tid; i < n4; i += GT) {
        const int r = (int)(i >> 9), c4 = (int)(i & 511);
        const float rs = __builtin_amdgcn_rsqf(ss[r] * (1.0f / D) + EPS);
        const f32x4 x = *(const f32x4*)(out + i * 4), gg = *(const f32x4*)(gn + 4 * c4);
        *(f32x4*)(out + i * 4) = x * rs * gg;
    }
}

constexpr int N_PHASES = 11;
__global__ void __launch_bounds__(NTHREADS, 2) fwd_kernel(Args args) {
    extern __shared__ __attribute__((aligned(16))) unsigned char lds_raw[];
    LAS unsigned char* lds = (LAS unsigned char*)lds_raw;
    volatile LAS unsigned* MISC = (volatile LAS unsigned*)(lds + MISC_OFF);
    ArgsP ap = (ArgsP)__builtin_amdgcn_kernarg_segment_ptr();
    const int tid = threadIdx.x, G = gridDim.x;
    unsigned char* ws = ARG_WS;
    if (tid < 64) MISC[tid] = 0u;
    __syncthreads();
    const int lo = ap->ph_lo, hi = ap->ph_hi;
    const bool one_launch = (hi - lo) > 1;
    XcdBarrier bar; bar.bar = (unsigned*)(ws + WS_CTL); bar.x = 0; bar.st = nullptr;
    if (one_launch) bar = xcd_barrier_post((unsigned*)(ws + WS_CTL), MISC + 8);
#define IN(k) (lo <= (k) && (k) < hi)
#define SEAM(k) do { if (IN(k) && IN((k) + 1)) xcd_barrier(bar); } while (0)

    float* SS = (float*)(ws + WS_SS);
    bf16_t* XNB = (bf16_t*)(ws + WS_XNB); bf16_t* ACT = (bf16_t*)(ws + WS_ACT); bf16_t* MIX = (bf16_t*)(ws + WS_MIX); bf16_t* PPB = (bf16_t*)(ws + WS_PP); bf16_t* PB = (bf16_t*)(ws + WS_PB);
    float* X = ARG_OUT;

    if (IN(0)) {
        p0_prologue(ap, lds, tid, G);
        if (IN(1)) { if (MK_N_LAUNCHES == 1) { cg::this_grid().sync(); } else xcd_barrier(bar); }
    }
    if (IN(1)) {
        pg8::Gemm g{PB, (const bf16_t*)(ws + WS_WPP), MP, D, PLE}; pg8::StaticOrder S; S.init(MP, D, G, (int)blockIdx.x);
        pg8::Epi<pg8::EP_PP> E{}; E.outb = PPB;
        pg8::gemm_phase(lds, g, S, E);
    }
    if (IN(2)) {
        pg8::Gemm g{XNB, (const bf16_t*)(ws + WS_W1IN), MP, 2 * DFF, D}; pg8::StaticOrder S; S.init(MP, 2 * DFF, G, (int)blockIdx.x);
        pg8::Epi<pg8::EP_SWIGLU> E{}; E.ss_in = SS; E.outb = ACT;
        pg8::gemm_phase(lds, g, S, E);
        SEAM(2);
    }
    if (IN(3)) {
        pg8::Gemm g{ACT, (const bf16_t*)(ws + WS_W1OUT), MP, D, DFF}; pg8::StaticOrder S; S.init(MP, D, G, (int)blockIdx.x);
        pg8::Epi<pg8::EP_RESID> E{}; E.ss_out = SS + MP; E.res0 = ARG_IN(0); E.res1 = ARG_IN(1); E.outf = X; E.outb = XNB; E.scale = 0.5f;
        pg8::gemm_phase(lds, g, S, E);
        SEAM(3);
    }
    if (IN(4)) {
        pg8::Gemm g{XNB, (const bf16_t*)(ws + WS_WIN), MP, 3072, D}; pg8::StaticOrder S; S.init(MP, 3072, G, (int)blockIdx.x);
        pg8::Epi<pg8::EP_WIN> E{}; E.ss_in = SS + MP; E.V = (float*)(ws + WS_V); E.U = (float*)(ws + WS_U);
        pg8::gemm_phase(lds, g, S, E);
        SEAM(4);
    }
    if (IN(5)) {
        p4_mix(ap, lds, tid, G);
        SEAM(5);
    }
    if (IN(6)) {
        pg8::Gemm g{MIX, (const bf16_t*)(ws + WS_WOUT), MP, D, D}; pg8::StaticOrder S; S.init(MP, D, G, (int)blockIdx.x);
        pg8::Epi<pg8::EP_RESID> E{}; E.ss_out = SS + 2 * MP; E.res0 = X; E.res1 = X + (size_t)NPROMPT * D; E.outf = X; E.outb = XNB; E.scale = 1.0f;
        pg8::gemm_phase(lds, g, S, E);
        SEAM(6);
    }
    if (IN(7)) {
        pg8::Gemm g{XNB, (const bf16_t*)(ws + WS_W2IN), MP, 2 * DFF, D}; pg8::StaticOrder S; S.init(MP, 2 * DFF, G, (int)blockIdx.x);
        pg8::Epi<pg8::EP_SWIGLU> E{}; E.ss_in = SS + 2 * MP; E.outb = ACT;
        pg8::gemm_phase(lds, g, S, E);
        SEAM(7);
    }
    if (IN(8)) {
        pg8::Gemm g{ACT, (const bf16_t*)(ws + WS_W2OUT), MP, D, DFF}; pg8::StaticOrder S; S.init(MP, D, G, (int)blockIdx.x);
        pg8::Epi<pg8::EP_RESID> E{}; E.ss_out = SS + 3 * MP; E.res0 = X; E.res1 = X + (size_t)NPROMPT * D; E.outf = X; E.outb = XNB; E.scale = 0.5f;
        pg8::gemm_phase(lds, g, S, E);
        SEAM(8);
    }
    if (IN(9)) {
        pg8::Gemm g{XNB, (const bf16_t*)(ws + WS_WPG), MP, D, D}; pg8::StaticOrder S; S.init(MP, D, G, (int)blockIdx.x);
        pg8::Epi<pg8::EP_PLE> E{}; E.ss_in = SS + 3 * MP; E.ss_out = SS + 4 * MP; E.outf = X; E.pp = PPB;
        pg8::gemm_phase(lds, g, S, E);
        SEAM(9);
    }
    if (IN(10)) p9_final(ap, tid, G);
#undef IN
#undef SEAM
}

extern "C" void kernel_launch(void* const* d_in, const int* in_sizes, int n_in, void* d_out, int out_size, void* d_ws, size_t ws_size, hipStream_t stream) {
    static int grid = 0;
    if (grid == 0) {
        if (n_in != 25 || (size_t)out_size != OUT_END || ws_size < WS_END) {
            fprintf(stderr, "kernel_launch: built for 25 inputs, %zu outputs, >= %zu bytes of workspace; got n_in %d, out %d, ws %zu; nothing launched\n", (size_t)OUT_END, (size_t)WS_END, n_in, out_size, ws_size);
            grid = -1; return; }
        int dev = 0, cus = 0, per_cu = 0;
        if (hipGetDevice(&dev) != hipSuccess || hipDeviceGetAttribute(&cus, hipDeviceAttributeMultiprocessorCount, dev) != hipSuccess) { fprintf(stderr, "kernel_launch: device query failed\n"); grid = -1; return; }
        if (hipFuncSetAttribute((const void*)fwd_kernel, hipFuncAttributeMaxDynamicSharedMemorySize, LDS_BYTES) != hipSuccess) { fprintf(stderr, "kernel_launch: hipFuncSetAttribute failed\n"); grid = -1; return; }
        if (hipOccupancyMaxActiveBlocksPerMultiprocessor(&per_cu, (const void*)fwd_kernel, NTHREADS, LDS_BYTES) != hipSuccess || per_cu < 1) { fprintf(stderr, "kernel_launch: occupancy query says %d blocks per CU\n", per_cu); (void)hipGetLastError(); per_cu = 1; }
        grid = cus * 1;
        fprintf(stderr, "kernel_launch: %d CUs, occupancy query %d block(s)/CU, grid %d, LDS %d B, ws %zu B (need %zu)\n", cus, per_cu, grid, LDS_BYTES, ws_size, (size_t)WS_END);
    }
    if (grid < 0) return;
    if (hipMemsetAsync((char*)d_ws + WS_CTL, 0, CTL_BYTES, stream) != hipSuccess) { fprintf(stderr, "kernel_launch: memset failed\n"); return; }
    Args a{};
    for (int i = 0; i < 25; ++i) a.in[i] = (const float*)d_in[i];
    a.out = (float*)d_out; a.ws = (unsigned char*)d_ws;
#if MK_N_LAUNCHES == 1
    a.ph_lo = 0; a.ph_hi = N_PHASES;
    void* kargs[] = {&a};
    hipError_t e = hipLaunchCooperativeKernel((const void*)fwd_kernel, dim3(grid), dim3(NTHREADS), kargs, LDS_BYTES, stream);
    if (e != hipSuccess) fprintf(stderr, "kernel_launch: cooperative launch failed: %s (grid %d)\n", hipGetErrorString(e), grid);
#else
    for (int ph = 0; ph < N_PHASES; ++ph) {
        a.ph_lo = ph; a.ph_hi = ph + 1;
        hipLaunchKernelGGL(fwd_kernel, dim3(grid), dim3(NTHREADS), LDS_BYTES, stream, a);
        const hipError_t le = hipPeekAtLastError();
        if (le != hipSuccess) { fprintf(stderr, "kernel_launch: launch %d failed: %s\n", ph, hipGetErrorName(le)); break; }
    }
#endif
}
```

```cpp
#include <hip/hip_runtime.h>
#include <hip/hip_cooperative_groups.h>
#include <cstdio>
#include <cstdint>
namespace cg = cooperative_groups;

#ifndef MK_N_LAUNCHES
#define MK_N_LAUNCHES 1
#endif

#ifndef DUP_PHASE
#define DUP_PHASE -1
#endif
#ifndef TIMING_A
#define TIMING_A -1
#define TIMING_B -1
#endif
#define LAS __attribute__((address_space(3)))
#define GAS __attribute__((address_space(1)))
typedef unsigned short bf16_t;
typedef short bf16x8 __attribute__((ext_vector_type(8)));
typedef float f32x4 __attribute__((ext_vector_type(4)));
typedef float f32x2 __attribute__((ext_vector_type(2)));
typedef unsigned u32x4 __attribute__((ext_vector_type(4)));
typedef unsigned u32x2 __attribute__((ext_vector_type(2)));

constexpr int D = 2048, DFF = 5632, NPROMPT = 8192, NSAMP = 128, NTOK = NPROMPT + NSAMP, MP = 8448  , SEQ = 2048;
constexpr int CDIM = 1024, PDIM = 1024, PLE = 256, NBATCH = 4;
constexpr float EPS = 1e-6f;
constexpr int NWAVES = 8, NTHREADS = 512;

constexpr size_t WS_CTL = 0, CTL_BYTES = 65536;
constexpr size_t WS_W1IN = WS_CTL + CTL_BYTES;
constexpr size_t WS_W1OUT = WS_W1IN + (size_t)2 * DFF * D * 2;
constexpr size_t WS_W2IN = WS_W1OUT + (size_t)D * DFF * 2;
constexpr size_t WS_W2OUT = WS_W2IN + (size_t)2 * DFF * D * 2;
constexpr size_t WS_WIN = WS_W2OUT + (size_t)D * DFF * 2;
constexpr size_t WS_WOUT = WS_WIN + (size_t)3072 * D * 2;
constexpr size_t WS_WPG = WS_WOUT + (size_t)D * D * 2;
constexpr size_t WS_WPP = WS_WPG + (size_t)D * D * 2;
constexpr size_t WS_PW = WS_WPP + (size_t)D * PLE * 2;
constexpr size_t WS_XNB = WS_PW + (size_t)4 * 256 * 256 * 2;
constexpr size_t WS_ACT = WS_XNB + (size_t)MP * D * 2;
constexpr size_t WS_V = WS_ACT, WS_U = WS_ACT + (size_t)MP * CDIM * 4;
constexpr size_t WS_MIX = WS_ACT + (size_t)MP * DFF * 2;
constexpr size_t WS_PP = WS_MIX + (size_t)MP * D * 2;
constexpr size_t WS_PB = WS_PP + (size_t)MP * D * 2;
constexpr size_t WS_SS = WS_PB + (size_t)MP * PLE * 2;
constexpr size_t WS_END = WS_SS + (size_t)5 * MP * 4;
static_assert(WS_U + (size_t)MP * PDIM * 4 <= WS_ACT + (size_t)NTOK * DFF * 2, "V/U overlay must not reach the act pad rows");

constexpr size_t OUT_Y = 0, OUT_NCP = (size_t)NTOK * D, OUT_NCS = OUT_NCP + (size_t)NBATCH * 30 * CDIM, OUT_NPP = OUT_NCS + (size_t)NSAMP * 30 * CDIM,
                 OUT_NPS = OUT_NPP + (size_t)NBATCH * 15 * PDIM, OUT_END = OUT_NPS + (size_t)NSAMP * 15 * PDIM;

__device__ __forceinline__ unsigned cvt_pk_bf16(float lo, float hi) { unsigned r; asm volatile("v_cvt_pk_bf16_f32 %0, %1, %2" : "=v"(r) : "v"(lo), "v"(hi)); return r; }
__device__ __forceinline__ float bf_lo(unsigned w) { return __uint_as_float(w << 16); }
__device__ __forceinline__ float bf_hi(unsigned w) { return __uint_as_float(w & 0xffff0000u); }
__device__ __forceinline__ float sigmoidf_fast(float x) { return __builtin_amdgcn_rcpf(1.0f + __builtin_amdgcn_exp2f(-1.44269504089f * x)); }
__device__ __forceinline__ float wave_sum(float v) {
#pragma unroll
    for (int o = 1; o < 64; o <<= 1) v += __shfl_xor(v, o);
    return v;
}
#define LDS_WAIT() asm volatile("s_waitcnt lgkmcnt(0)" ::: "memory")
#define VM_WAIT() asm volatile("s_waitcnt vmcnt(0)" ::: "memory")

namespace pg8 {
constexpr int BM = 256, BK = 64, HALF = 128, HTB = HALF * BK * 2  , STAGE_BYTES = 8 * HTB, NXCD = 8, WGM = 8;
__host__ __device__ __forceinline__ int lds_byte(int r, int c) { const int st = (r >> 4) * 2 + (c >> 5), rr = r & 15, cc = c & 31, ob = rr * 64 + cc * 2; return st * 1024 + (ob ^ (((ob >> 9) & 1) << 5)); }
__host__ __device__ __forceinline__ void stage_rc(int b, int& R, int& C) { const int st = b / 1024, sb = b % 1024, swz = sb ^ (((sb >> 9) & 1) << 5); R = (st >> 1) * 16 + swz / 64; C = (st & 1) * 32 + (swz % 64) / 2; }
__host__ __device__ __forceinline__ int perm32(int rho) { const int n = rho >> 4, i = rho & 15; return 8 * (i >> 2) + 4 * n + (i & 3); }

struct Unit { int pm, pn; };
struct Gemm { const bf16_t* A; const bf16_t* Bt; int M, N, K; };

struct StaticOrder {
    int nM, nN, nwg, G, c;
    __host__ __device__ void init(int M, int N, int G_, int c_) { nM = M / BM; nN = N / BM; nwg = nM * nN; G = G_; c = c_; }
    __host__ __device__ bool next(int i, Unit& u) const {
        const long L = (long)i * G + c; if (L >= nwg) return false;
        int wgid = (int)L; { const int q = nwg / NXCD, r = nwg % NXCD, xcd = wgid % NXCD, off = wgid / NXCD; wgid = (xcd < r ? xcd * (q + 1) : r * (q + 1) + (xcd - r) * q) + off; }
        const int nig = WGM * nN, gid = wgid / nig, fm = gid * WGM, gsz = (nM - fm) < WGM ? (nM - fm) : WGM;
        u.pm = fm + ((wgid % nig) % gsz); u.pn = (wgid % nig) / gsz; return true;
    }
    __device__ __forceinline__ void a_ready(const Unit&) const {}
    __device__ __forceinline__ void done(const Unit&) const {}
};

enum { EP_SWIGLU = 0, EP_RESID = 1, EP_WIN = 2, EP_PP = 3, EP_PLE = 4 };
template <int MODE> struct Epi {
    static constexpr bool PERM = true, AFTER_DRAIN = false;
    const float* ss_in;
    float* ss_out;
    const float* res0;
    const float* res1;
    float* outf;
    bf16_t* outb;
    float* V; float* U;
    const bf16_t* pp;
    float scale;
    __device__ __forceinline__ void operator()(const f32x4 (&acc)[2][2][4][2], const Unit& u, int wr, int wc, int fr, int fq) const {
        const int rowb = u.pm * BM + wr * 64 + fr;
        const int cw = wc * 32 + 8 * fq;
#pragma unroll
        for (int ai = 0; ai < 2; ++ai) {
            if (u.pm * BM + ai * HALF >= NTOK) continue;
#pragma unroll
            for (int m = 0; m < 4; ++m) {
                const int r = rowb + ai * HALF + m * 16;
                float rs = 1.0f;
                if (MODE == EP_SWIGLU || MODE == EP_WIN || MODE == EP_PLE) rs = __builtin_amdgcn_rsqf(ss_in[r] * (1.0f / D) + EPS);
                if (MODE == EP_SWIGLU) {
                    f32x4 a[2];
#pragma unroll
                    for (int n = 0; n < 2; ++n)
#pragma unroll
                        for (int j = 0; j < 4; ++j) { const float g = acc[ai][0][m][n][j] * rs, up = acc[ai][1][m][n][j] * rs; a[n][j] = g * sigmoidf_fast(g) * up; }
                    u32x4 w; w.x = cvt_pk_bf16(a[0][0], a[0][1]); w.y = cvt_pk_bf16(a[0][2], a[0][3]); w.z = cvt_pk_bf16(a[1][0], a[1][1]); w.w = cvt_pk_bf16(a[1][2], a[1][3]);
                    *(u32x4*)(outb + (size_t)r * DFF + u.pn * HALF + cw) = w;
                } else if (MODE == EP_RESID) {
                    const float* rp = (u.pm < NPROMPT / BM ? res0 + (size_t)r * D : res1 + (size_t)(r - NPROMPT) * D) + u.pn * BM + cw;
                    float* op = outf + (size_t)r * D + u.pn * BM + cw; bf16_t* ob = outb + (size_t)r * D + u.pn * BM + cw;
                    float sq = 0.f;
#pragma unroll
                    for (int bj = 0; bj < 2; ++bj) {
                        const f32x4 x0 = *(const f32x4*)(rp + bj * HALF), x1 = *(const f32x4*)(rp + bj * HALF + 4);
                        const f32x4 y0 = x0 + acc[ai][bj][m][0] * scale, y1 = x1 + acc[ai][bj][m][1] * scale;
                        *(f32x4*)(op + bj * HALF) = y0; *(f32x4*)(op + bj * HALF + 4) = y1;
                        u32x4 w; w.x = cvt_pk_bf16(y0[0], y0[1]); w.y = cvt_pk_bf16(y0[2], y0[3]); w.z = cvt_pk_bf16(y1[0], y1[1]); w.w = cvt_pk_bf16(y1[2], y1[3]);
                        *(u32x4*)(ob + bj * HALF) = w;
                        sq += (y0[0] * y0[0] + y0[1] * y0[1]) + (y0[2] * y0[2] + y0[3] * y0[3]) + (y1[0] * y1[0] + y1[1] * y1[1]) + (y1[2] * y1[2] + y1[3] * y1[3]);
                    }
                    sq += __shfl_xor(sq, 16); sq += __shfl_xor(sq, 32);
                    if (fq == 0) unsafeAtomicAdd(ss_out + r, sq);
                } else if (MODE == EP_WIN) {
                    if (u.pn < 8) {
                        float* vp = V + (size_t)r * CDIM + u.pn * HALF + cw;
#pragma unroll
                        for (int n = 0; n < 2; ++n) { f32x4 o;
#pragma unroll
                            for (int j = 0; j < 4; ++j) o[j] = (acc[ai][0][m][n][j] * rs) * sigmoidf_fast(acc[ai][1][m][n][j] * rs);
                            *(f32x4*)(vp + 4 * n) = o; }
                    } else {
                        float* upt = U + (size_t)r * PDIM + (u.pn - 8) * BM + cw;
#pragma unroll
                        for (int bj = 0; bj < 2; ++bj)
#pragma unroll
                            for (int n = 0; n < 2; ++n) *(f32x4*)(upt + bj * HALF + 4 * n) = acc[ai][bj][m][n] * rs;
                    }
                } else if (MODE == EP_PP) {
                    bf16_t* ob = outb + (size_t)r * D + u.pn * BM + cw;
#pragma unroll
                    for (int bj = 0; bj < 2; ++bj) { const f32x4 y0 = acc[ai][bj][m][0], y1 = acc[ai][bj][m][1];
                        u32x4 w; w.x = cvt_pk_bf16(y0[0], y0[1]); w.y = cvt_pk_bf16(y0[2], y0[3]); w.z = cvt_pk_bf16(y1[0], y1[1]); w.w = cvt_pk_bf16(y1[2], y1[3]);
                        *(u32x4*)(ob + bj * HALF) = w; }
                } else {
                    float* op = outf + (size_t)r * D + u.pn * BM + cw; const bf16_t* pb = pp + (size_t)r * D + u.pn * BM + cw;
                    float sq = 0.f;
#pragma unroll
                    for (int bj = 0; bj < 2; ++bj) {
                        const f32x4 x0 = *(const f32x4*)(op + bj * HALF), x1 = *(const f32x4*)(op + bj * HALF + 4);
                        const u32x4 pw = *(const u32x4*)(pb + bj * HALF);
                        const f32x4 p0 = {bf_lo(pw.x), bf_hi(pw.x), bf_lo(pw.y), bf_hi(pw.y)}, p1 = {bf_lo(pw.z), bf_hi(pw.z), bf_lo(pw.w), bf_hi(pw.w)};
                        f32x4 y0, y1;
#pragma unroll
                        for (int j = 0; j < 4; ++j) { y0[j] = x0[j] + sigmoidf_fast(acc[ai][bj][m][0][j] * rs) * p0[j]; y1[j] = x1[j] + sigmoidf_fast(acc[ai][bj][m][1][j] * rs) * p1[j]; }
                        *(f32x4*)(op + bj * HALF) = y0; *(f32x4*)(op + bj * HALF + 4) = y1;
                        sq += (y0[0] * y0[0] + y0[1] * y0[1]) + (y0[2] * y0[2] + y0[3] * y0[3]) + (y1[0] * y1[0] + y1[1] * y1[1]) + (y1[2] * y1[2] + y1[3] * y1[3]);
                    }
                    sq += __shfl_xor(sq, 16); sq += __shfl_xor(sq, 32);
                    if (fq == 0) unsafeAtomicAdd(ss_out + r, sq);
                }
            }
        }
    }
};

template <class Epi, class Sched, bool ALIGN_EPI = true, bool SP2 = true>
__device__ __forceinline__ void gemm_phase(LAS unsigned char* lds, const Gemm g, const Sched& S, const Epi& E) {
    int tid_ = threadIdx.x; asm volatile("" : "+v"(tid_));
    const int tid = tid_, wid = __builtin_amdgcn_readfirstlane(tid >> 6), lane = tid & 63, wr = wid >> 2, wc = wid & 3, fr = lane & 15, fq = lane >> 4;
    const int K = g.K, nt = K / BK;
    unsigned voffA[2], voffB[2];
#pragma unroll
    for (int i = 0; i < 2; ++i) { int R, C; stage_rc(tid * 16 + i * 8192, R, C); const int Rb = Epi::PERM ? ((R & ~31) + perm32(R & 31)) : R;
        voffA[i] = (unsigned)(R * K + C) * 2u; voffB[i] = (unsigned)(Rb * K + C) * 2u; }
    const size_t kstep = (size_t)(BK * 2);
    const size_t hstep = (size_t)HALF * K * 2;
    const size_t tstep = 2 * hstep;
    const unsigned ldsw = (unsigned)wid * 1024u;
    const int aoff = lds_byte(wr * 64 + fr, fq * 8), boff = lds_byte(wc * 32 + fr, fq * 8);
#define PG8_SA(b, h) (((b) * 2 + (h)) * HTB)
#define PG8_SB(b, h) ((4 + (b) * 2 + (h)) * HTB)
#define PG8_STAGE(bufoff, gbase, voff) do { _Pragma("unroll") for (int _i = 0; _i < 2; ++_i) \
        __builtin_amdgcn_global_load_lds((const unsigned*)((const char*)(gbase) + (voff)[_i]), (LAS unsigned*)(lds + (bufoff) + ldsw + _i * 8192), 16, 0, 0); } while (0)
#define PG8_LDA(dst, b, h) do { _Pragma("unroll") for (int m = 0; m < 4; ++m) _Pragma("unroll") for (int k = 0; k < 2; ++k) dst[m][k] = *(const LAS bf16x8*)(lds + PG8_SA(b, h) + aoff + m * 2048 + k * 1024); } while (0)
#define PG8_LDB(dst, b, h) do { _Pragma("unroll") for (int n = 0; n < 2; ++n) _Pragma("unroll") for (int k = 0; k < 2; ++k) dst[n][k] = *(const LAS bf16x8*)(lds + PG8_SB(b, h) + boff + n * 2048 + k * 1024); } while (0)
#define PG8_MMA(ai, bj, At, Bt) do { __builtin_amdgcn_s_setprio(1); _Pragma("unroll") for (int m = 0; m < 4; ++m) _Pragma("unroll") for (int n = 0; n < 2; ++n) _Pragma("unroll") for (int k = 0; k < 2; ++k) \
        acc[ai][bj][m][n] = __builtin_amdgcn_mfma_f32_16x16x32_bf16(Bt[n][k], At[m][k], acc[ai][bj][m][n], 0, 0, 0); __builtin_amdgcn_s_setprio(0); } while (0)
#define PG8_WAIT_V(n) asm volatile("s_waitcnt vmcnt(" #n ")" ::: "memory")
#define PG8_WAIT_L(n) asm volatile("s_waitcnt lgkmcnt(" #n ")" ::: "memory")
#define PG8_BAR __builtin_amdgcn_s_barrier()
#define PG8_SCHED __builtin_amdgcn_sched_barrier(0)
    Unit cur, nxt; int ui = 0;
    if (!S.next(0, cur)) return;
    f32x4 acc[2][2][4][2];
#pragma unroll
    for (int a = 0; a < 2; ++a)
#pragma unroll
        for (int b = 0; b < 2; ++b)
#pragma unroll
            for (int m = 0; m < 4; ++m)
#pragma unroll
                for (int n = 0; n < 2; ++n) acc[a][b][m][n] = (f32x4){0.f, 0.f, 0.f, 0.f};
    bf16x8 At[4][2], B0[2][2], B1[2][2];
    const char* cA = (const char*)g.A + (size_t)cur.pm * tstep; const char* cB = (const char*)g.Bt + (size_t)cur.pn * tstep;
    S.a_ready(cur);
    if constexpr (SP2) {
        PG8_STAGE(PG8_SB(0, 0), cB, voffB); PG8_STAGE(PG8_SB(0, 1), cB + hstep, voffB); PG8_STAGE(PG8_SA(0, 0), cA, voffA); PG8_STAGE(PG8_SA(0, 1), cA + hstep, voffA);
        if (wr == 1) PG8_BAR;
        PG8_WAIT_V(2); PG8_BAR;
        PG8_STAGE(PG8_SB(1, 0), cB + kstep, voffB); PG8_STAGE(PG8_SA(1, 0), cA + kstep, voffA); PG8_STAGE(PG8_SB(1, 1), cB + hstep + kstep, voffB);
        PG8_WAIT_V(6); PG8_BAR;
    } else {
        PG8_STAGE(PG8_SB(0, 0), cB, voffB); PG8_STAGE(PG8_SA(0, 0), cA, voffA); PG8_STAGE(PG8_SB(0, 1), cB + hstep, voffB); PG8_STAGE(PG8_SA(0, 1), cA + hstep, voffA);
        if (wr == 1) PG8_BAR;
        PG8_WAIT_V(4); PG8_BAR;
        PG8_STAGE(PG8_SB(1, 0), cB + kstep, voffB); PG8_STAGE(PG8_SA(1, 0), cA + kstep, voffA); PG8_STAGE(PG8_SB(1, 1), cB + hstep + kstep, voffB);
        PG8_WAIT_V(6); PG8_BAR;
    }
    for (;;) {
        const bool has_next = S.next(ui + 1, nxt);
        const char* nA = has_next ? (const char*)g.A + (size_t)nxt.pm * tstep : cA; const char* nB = has_next ? (const char*)g.Bt + (size_t)nxt.pn * tstep : cB;
#pragma nounroll
        for (int t = 0; t < nt; t += 2) {
            const bool last = (t == nt - 2);
            const char* a1 = cA + (size_t)(t + 1) * kstep;
            const char* a2 = last ? nA : cA + (size_t)(t + 2) * kstep; const char* b2 = last ? nB : cB + (size_t)(t + 2) * kstep;
            const char* a3 = a2 + kstep; const char* b3 = b2 + kstep;
            if (last && has_next) S.a_ready(nxt);
            if constexpr (SP2) {
            PG8_LDB(B0, 0, 0); PG8_LDB(B1, 0, 1); PG8_SCHED; PG8_LDA(At, 0, 0); PG8_STAGE(PG8_SA(1, 1), a1 + hstep, voffA);
            PG8_WAIT_V(8); PG8_WAIT_L(0); PG8_BAR; PG8_MMA(0, 0, At, B0); PG8_MMA(0, 1, At, B1); PG8_BAR; PG8_SCHED;
            PG8_LDA(At, 0, 1); PG8_STAGE(PG8_SB(0, 0), b2, voffB); PG8_STAGE(PG8_SB(0, 1), b2 + hstep, voffB); PG8_STAGE(PG8_SA(0, 0), a2, voffA);
            PG8_WAIT_V(8); PG8_WAIT_L(0); PG8_BAR; PG8_MMA(1, 0, At, B0); PG8_MMA(1, 1, At, B1); PG8_BAR; PG8_SCHED;
            PG8_LDB(B0, 1, 0); PG8_LDB(B1, 1, 1); PG8_SCHED; PG8_LDA(At, 1, 0); PG8_STAGE(PG8_SA(0, 1), a2 + hstep, voffA);
            PG8_WAIT_V(8); PG8_WAIT_L(0); PG8_BAR; PG8_MMA(0, 0, At, B0); PG8_MMA(0, 1, At, B1); PG8_BAR; PG8_SCHED;
            PG8_LDA(At, 1, 1); PG8_STAGE(PG8_SB(1, 0), b3, voffB); PG8_STAGE(PG8_SB(1, 1), b3 + hstep, voffB); PG8_STAGE(PG8_SA(1, 0), a3, voffA);
            PG8_WAIT_V(8); PG8_WAIT_L(0); PG8_BAR; PG8_MMA(1, 0, At, B0); PG8_MMA(1, 1, At, B1); PG8_BAR; PG8_SCHED;
            } else {
            PG8_LDB(B0, 0, 0); PG8_SCHED; PG8_LDA(At, 0, 0); PG8_STAGE(PG8_SA(1, 1), a1 + hstep, voffA);
            PG8_WAIT_L(8); PG8_BAR; PG8_WAIT_L(0); PG8_MMA(0, 0, At, B0); PG8_BAR; PG8_SCHED;
            PG8_LDB(B1, 0, 1); PG8_STAGE(PG8_SB(0, 0), b2, voffB);
            PG8_BAR; PG8_WAIT_L(0); PG8_MMA(0, 1, At, B1); PG8_BAR;
            PG8_LDA(At, 0, 1); PG8_STAGE(PG8_SA(0, 0), a2, voffA);
            PG8_BAR; PG8_WAIT_L(0); PG8_MMA(1, 0, At, B0); PG8_BAR; PG8_SCHED;
            PG8_STAGE(PG8_SB(0, 1), b2 + hstep, voffB);
            PG8_WAIT_V(6); PG8_BAR; PG8_MMA(1, 1, At, B1); PG8_BAR;
            PG8_LDB(B0, 1, 0); PG8_SCHED; PG8_LDA(At, 1, 0); PG8_STAGE(PG8_SA(0, 1), a2 + hstep, voffA);
            PG8_WAIT_L(8); PG8_BAR; PG8_WAIT_L(0); PG8_MMA(0, 0, At, B0); PG8_BAR; PG8_SCHED;
            PG8_LDB(B1, 1, 1); PG8_STAGE(PG8_SB(1, 0), b3, voffB);
            PG8_BAR; PG8_WAIT_L(0); PG8_MMA(0, 1, At, B1); PG8_BAR;
            PG8_LDA(At, 1, 1); PG8_STAGE(PG8_SA(1, 0), a3, voffA);
            PG8_BAR; PG8_WAIT_L(0); PG8_MMA(1, 0, At, B0); PG8_BAR; PG8_SCHED;
            PG8_STAGE(PG8_SB(1, 1), b3 + hstep, voffB);
            PG8_WAIT_V(6); PG8_BAR; PG8_MMA(1, 1, At, B1); PG8_BAR;
            }
        }
        if constexpr (ALIGN_EPI) { if (wr == 0) PG8_BAR; }
        if constexpr (!Epi::AFTER_DRAIN) { E(acc, cur, wr, wc, fr, fq); S.done(cur); }
        if (!has_next) break;
#pragma unroll
        for (int a = 0; a < 2; ++a)
#pragma unroll
            for (int b = 0; b < 2; ++b)
#pragma unroll
                for (int m = 0; m < 4; ++m)
#pragma unroll
                    for (int n = 0; n < 2; ++n) acc[a][b][m][n] = (f32x4){0.f, 0.f, 0.f, 0.f};
        cur = nxt; cA = nA; cB = nB; ++ui;
        if constexpr (ALIGN_EPI) { if (wr == 1) PG8_BAR; }
    }
    PG8_WAIT_V(0);
    if constexpr (!ALIGN_EPI) { if (wr == 0) PG8_BAR; }
    PG8_BAR;
#undef PG8_SA
#undef PG8_SB
#undef PG8_STAGE
#undef PG8_LDA
#undef PG8_LDB
#undef PG8_MMA
#undef PG8_WAIT_V
#undef PG8_WAIT_L
#undef PG8_BAR
#undef PG8_SCHED
}
}

#define XB_TMO      128
#define XB_XCNT(j)  (256  + 64 * (j))
#define XB_XSUB(j)  (1280 + 64 * (j))
#define XB_XGEN(j)  (2304 + 64 * (j))
#define XB_TOP      3328
#define XB_TOPGEN   3392
#define XCD_BAR_WORDS 3456
#define XB_SPIN_CAP (1u << 18)
__device__ __forceinline__ unsigned xb_ld(unsigned* p)              { return __hip_atomic_load(p, __ATOMIC_RELAXED, __HIP_MEMORY_SCOPE_AGENT); }
__device__ __forceinline__ unsigned xb_add(unsigned* p, unsigned v) { return __hip_atomic_fetch_add(p, v, __ATOMIC_RELAXED, __HIP_MEMORY_SCOPE_AGENT); }
__device__ __forceinline__ unsigned xb_xcc_id() { return (unsigned)__builtin_amdgcn_s_getreg((3 << 11) | 20) & 0xFu; }
#define XB_SPIN(cond, bar) do { unsigned _sp = 0; while (cond) { __builtin_amdgcn_s_sleep(1); \
    if ((++_sp & 255u) == 0u) { if (xb_ld(&(bar)[XB_TMO])) break; if (_sp > XB_SPIN_CAP) { atomicAdd(&(bar)[XB_TMO], 1u); break; } } } } while (0)
struct XcdBarrier { unsigned* bar; unsigned x; volatile LAS unsigned* st; };
__device__ __forceinline__ XcdBarrier xcd_barrier_post(unsigned* bar, volatile LAS unsigned* st) {
    XcdBarrier b; b.bar = bar; b.x = xb_xcc_id(); b.st = st;
    if (threadIdx.x == 0) (void)xb_add(&bar[XB_XCNT(b.x)], 1u);
    return b;
}
__device__ __forceinline__ void xcd_barrier_complete(unsigned* bar, unsigned x, unsigned& nloc, unsigned& nx) {
    const unsigned G = gridDim.x * gridDim.y * gridDim.z;
    unsigned sum, cnt, mine, sp = 0u;
    for (;;) {
        sum = 0u; cnt = 0u; mine = 0u;
#pragma unroll
        for (unsigned j = 0; j < 16; ++j) { const unsigned c = xb_ld(&bar[XB_XCNT(j)]); sum += c; cnt += (c > 0u) ? 1u : 0u; mine = (j == x) ? c : mine; }
        if (sum == G) break;
        __builtin_amdgcn_s_sleep(1);
        if ((++sp & 255u) == 0u) { if (xb_ld(&bar[XB_TMO])) break; if (sp > XB_SPIN_CAP) { atomicAdd(&bar[XB_TMO], 1u); break; } }
    }
    nloc = mine > 0u ? mine : 1u; nx = cnt > 0u ? cnt : 1u;
}
__device__ __forceinline__ void xcd_barrier(const XcdBarrier& b) {
    asm volatile("s_waitcnt vmcnt(0)" ::: "memory");
    __syncthreads();
    if (threadIdx.x == 0) {
        unsigned* bar = b.bar;
        __builtin_amdgcn_s_waitcnt(0);
        unsigned nloc = b.st[0], nx = b.st[1];
        if (nloc == 0u) { xcd_barrier_complete(bar, b.x, nloc, nx); b.st[0] = nloc; b.st[1] = nx; }
        const unsigned old = xb_add(&bar[XB_XSUB(b.x)], 1u);
        const unsigned gen = old / nloc;
        if (old + 1u == (gen + 1u) * nloc) {
            __builtin_amdgcn_fence(__ATOMIC_RELEASE, "agent");
            asm volatile("s_waitcnt vmcnt(0)" ::: "memory");
            const unsigned og = xb_add(&bar[XB_TOP], 1u);
            const unsigned tg = og / nx;
            if (og + 1u == (tg + 1u) * nx) xb_add(&bar[XB_TOPGEN], 1u);
            else XB_SPIN(xb_ld(&bar[XB_TOPGEN]) == tg, bar);
            __builtin_amdgcn_fence(__ATOMIC_ACQUIRE, "agent");
            xb_add(&bar[XB_XGEN(b.x)], 1u);
            asm volatile("s_waitcnt vmcnt(0)" ::: "memory");
        } else {
            XB_SPIN(xb_ld(&bar[XB_XGEN(b.x)]) == gen, bar);
            __builtin_amdgcn_fence(__ATOMIC_ACQUIRE, "agent");
            asm volatile("s_waitcnt vmcnt(0)" ::: "memory");
        }
    }
    __syncthreads();
}

constexpr int LDS_STAGE = pg8::STAGE_BYTES;
constexpr int MISC_OFF = LDS_STAGE, LDS_BYTES = LDS_STAGE + 256;

struct Args { const float* in[25]; float* out; unsigned char* ws; int ph_lo, ph_hi; };
typedef const Args __attribute__((address_space(4)))* ArgsP;
#define ARG_IN(i) ((const float*)(const GAS float*)ap->in[i])
#define ARG_OUT ((float*)(GAS float*)ap->out)
#define ARG_WS ((unsigned char*)(GAS unsigned char*)ap->ws)

__device__ __forceinline__ int map_row(int n, int rmap) {
    if (rmap == 1) { const int up = n >= DFF, j = up ? n - DFF : n; return ((j >> 7) << 8) + (up << 7) + (j & 127); }
    if (rmap == 2) { if (n >= 2048) return n; const int gt = n >= 1024, j = gt ? n - 1024 : n; return ((j >> 7) << 8) + (gt << 7) + (j & 127); }
    return n;
}
__device__ __forceinline__ void p0_transpose_item(const float* W, int K, int N, bf16_t* WT, int rmap, const float* gain, LAS float* scr, int item, int lane) {
    const int nblk = N / 32, kb = item / nblk, nb = item % nblk, k0 = 64 * kb, n0 = 32 * nb;
    const int n4 = (lane & 7) * 4;
#pragma unroll
    for (int i = 0; i < 8; ++i) {
        const int kk = i * 8 + (lane >> 3);
        f32x4 v = *(const f32x4*)(W + (size_t)(k0 + kk) * N + n0 + n4);
        if (gain) v = v * gain[k0 + kk];
        LAS float* s = scr + kk * 33 + n4;
        s[0] = v[0]; s[1] = v[1]; s[2] = v[2]; s[3] = v[3];
    }
    LDS_WAIT(); asm volatile("" ::: "memory");
    const int c = lane >> 3;
    const int d0 = map_row(n0, rmap);
#pragma unroll
    for (int j = 0; j < 4; ++j) { const int n = (lane & 7) + 8 * j; const LAS float* s = scr + (8 * c) * 33 + n;
        u32x4 o; o.x = cvt_pk_bf16(s[0 * 33], s[1 * 33]); o.y = cvt_pk_bf16(s[2 * 33], s[3 * 33]); o.z = cvt_pk_bf16(s[4 * 33], s[5 * 33]); o.w = cvt_pk_bf16(s[6 * 33], s[7 * 33]);
        *(u32x4*)(WT + (size_t)(d0 + n) * K + k0 + 8 * c) = o; }
    LDS_WAIT(); asm volatile("" ::: "memory");
}

__device__ __forceinline__ void p0_prologue(ArgsP ap, LAS unsigned char* lds, int tid, int G) {
    const int lane = tid & 63, wave = __builtin_amdgcn_readfirstlane(tid >> 6);
    LAS float* scr = (LAS float*)(lds + wave * 8448);
    const int gw = blockIdx.x * NWAVES + wave, NGW = G * NWAVES;
    unsigned char* ws = ARG_WS;
    constexpr int I_FI = (D / 64) * (2 * DFF / 32), I_FO = (DFF / 64) * (D / 32), I_WI = (D / 64) * (3072 / 32), I_DD = (D / 64) * (D / 32), I_PP = (PLE / 64) * (D / 32), I_PW = (256 / 64) * (256 / 32);
    constexpr int NW_ITEMS = 2 * I_FI + 2 * I_FO + I_WI + 2 * I_DD + I_PP + 4 * I_PW;
    for (int it = gw; it < NW_ITEMS; it += NGW) {
        int r = it;
        if (r < I_FI) { p0_transpose_item(ARG_IN(7), D, 2 * DFF, (bf16_t*)(ws + WS_W1IN), 1, ARG_IN(6), scr, r, lane); continue; } r -= I_FI;
        if (r < I_FI) { p0_transpose_item(ARG_IN(19), D, 2 * DFF, (bf16_t*)(ws + WS_W2IN), 1, ARG_IN(18), scr, r, lane); continue; } r -= I_FI;
        if (r < I_FO) { p0_transpose_item(ARG_IN(8), DFF, D, (bf16_t*)(ws + WS_W1OUT), 0, nullptr, scr, r, lane); continue; } r -= I_FO;
        if (r < I_FO) { p0_transpose_item(ARG_IN(20), DFF, D, (bf16_t*)(ws + WS_W2OUT), 0, nullptr, scr, r, lane); continue; } r -= I_FO;
        if (r < I_WI) { p0_transpose_item(ARG_IN(10), D, 3072, (bf16_t*)(ws + WS_WIN), 2, ARG_IN(9), scr, r, lane); continue; } r -= I_WI;
        if (r < I_DD) { p0_transpose_item(ARG_IN(17), D, D, (bf16_t*)(ws + WS_WOUT), 0, nullptr, scr, r, lane); continue; } r -= I_DD;
        if (r < I_DD) { p0_transpose_item(ARG_IN(22), D, D, (bf16_t*)(ws + WS_WPG), 0, ARG_IN(21), scr, r, lane); continue; } r -= I_DD;
        if (r < I_PP) { p0_transpose_item(ARG_IN(23), PLE, D, (bf16_t*)(ws + WS_WPP), 0, nullptr, scr, r, lane); continue; } r -= I_PP;
        { const int g = r / I_PW; p0_transpose_item(ARG_IN(15) + (size_t)g * 65536, 256, 256, (bf16_t*)(ws + WS_PW) + (size_t)g * 65536, 0, nullptr, scr, r % I_PW, lane); }
    }
    bf16_t* XNB = (bf16_t*)(ws + WS_XNB); bf16_t* PB = (bf16_t*)(ws + WS_PB); float* SS = (float*)(ws + WS_SS);
    for (int r = gw; r < NTOK; r += NGW) {
        const float* xr = r < NPROMPT ? ARG_IN(0) + (size_t)r * D : ARG_IN(1) + (size_t)(r - NPROMPT) * D;
        float sq = 0.f;
#pragma unroll
        for (int j = 0; j < 8; ++j) { const f32x4 v = *(const f32x4*)(xr + 4 * lane + 256 * j);
            sq += (v[0] * v[0] + v[1] * v[1]) + (v[2] * v[2] + v[3] * v[3]);
            u32x2 w; w.x = cvt_pk_bf16(v[0], v[1]); w.y = cvt_pk_bf16(v[2], v[3]);
            *(u32x2*)(XNB + (size_t)r * D + 4 * lane + 256 * j) = w; }
        sq = wave_sum(sq);
        if (lane == 0) SS[r] = sq;
        const float* pr = r < NPROMPT ? ARG_IN(4) + (size_t)r * PLE : ARG_IN(5) + (size_t)(r - NPROMPT) * PLE;
        const f32x4 v = *(const f32x4*)(pr + 4 * lane);
        u32x2 w; w.x = cvt_pk_bf16(v[0], v[1]); w.y = cvt_pk_bf16(v[2], v[3]);
        *(u32x2*)(PB + (size_t)r * PLE + 4 * lane) = w;
    }
    {
        const u32x4 z = {0u, 0u, 0u, 0u};
        const size_t gt = (size_t)blockIdx.x * NTHREADS + tid, GT = (size_t)G * NTHREADS;
        u32x4* p; size_t n;
        p = (u32x4*)(ws + WS_XNB + (size_t)NTOK * D * 2); n = (size_t)(MP - NTOK) * D * 2 / 16; for (size_t i = gt; i < n; i += GT) p[i] = z;
        p = (u32x4*)(ws + WS_ACT + (size_t)NTOK * DFF * 2); n = (size_t)(MP - NTOK) * DFF * 2 / 16; for (size_t i = gt; i < n; i += GT) p[i] = z;
        p = (u32x4*)(ws + WS_MIX + (size_t)NTOK * D * 2); n = (size_t)(MP - NTOK) * D * 2 / 16; for (size_t i = gt; i < n; i += GT) p[i] = z;
        p = (u32x4*)(ws + WS_PB + (size_t)NTOK * PLE * 2); n = (size_t)(MP - NTOK) * PLE * 2 / 16; for (size_t i = gt; i < n; i += GT) p[i] = z;
        p = (u32x4*)(ws + WS_SS + (size_t)MP * 4); n = (size_t)4 * MP * 4 / 16; for (size_t i = gt; i < n; i += GT) p[i] = z;
    }
}

constexpr int P4_RED = 126976, P4_FIN = 128000;
template <int W> __device__ __forceinline__ void pool_d_prompt(const float* U, int b, int t0r, int ch, LAS unsigned char* arow) {
    f32x2 xr[W + 15];
#pragma unroll
    for (int k = 0; k < W + 15; ++k) { const int t = t0r - (W - 1) + k; const f32x2 v = *(const f32x2*)(U + (size_t)(b * SEQ + (t > 0 ? t : 0)) * PDIM + ch); xr[k] = t >= 0 ? v : (f32x2){0.f, 0.f}; }
#pragma unroll
    for (int tt = 0; tt < 16; ++tt) { f32x2 s = xr[tt];
#pragma unroll
        for (int k = 1; k < W; ++k) s += xr[tt + k];
        const int t = t0r + tt; const float cnt = (float)(t + 1 < W ? t + 1 : W);
        const f32x2 dd = s / cnt - xr[tt + W - 1];
        *(LAS unsigned*)(arow + tt * 528) = cvt_pk_bf16(dd[0], dd[1]); }
}
template <int W> __device__ __forceinline__ void pool_d_sample(const float* U, const float* state, int b0r, int ch, LAS unsigned char* arow) {
#pragma unroll 4
    for (int tt = 0; tt < 16; ++tt) { const int b = b0r + tt; const f32x2 uc = *(const f32x2*)(U + (size_t)(NPROMPT + b) * PDIM + ch); f32x2 s = uc;
#pragma unroll
        for (int i = 1; i < W; ++i) s += *(const f32x2*)(state + ((size_t)b * 15 + (15 - i)) * PDIM + ch);
        const f32x2 dd = s * (1.0f / (float)W) - uc;
        *(LAS unsigned*)(arow + tt * 528) = cvt_pk_bf16(dd[0], dd[1]); }
}

template <int R> __device__ __forceinline__ void p4_conv_unit(int r0, const float* V, const float* state_conv, bf16_t* MIX, f32x2 cb, f32x2 lg, f32x2 lb, LAS unsigned char* lds, int tid, int lane, int wave) {
    const int c0 = 2 * tid;
    const LAS f32x2* wl = (const LAS f32x2*)(lds) + tid;
    f32x2 o[R];
    if constexpr (R == 16) {
        const int b = r0 >> 11, t0 = r0 & (SEQ - 1);
        f32x2 x[46];
#pragma unroll
        for (int k = 0; k < 46; ++k) { const int t = t0 - 30 + k; const f32x2 v = *(const f32x2*)(V + (size_t)(b * SEQ + (t > 0 ? t : 0)) * CDIM + c0); x[k] = t >= 0 ? v : (f32x2){0.f, 0.f}; }
#pragma unroll
        for (int tt = 0; tt < 16; ++tt) o[tt] = cb;
#pragma unroll
        for (int j = 0; j < 31; ++j) { const f32x2 wj = wl[j * 512];
#pragma unroll
            for (int tt = 0; tt < 16; ++tt) o[tt] += wj * x[tt + j]; }
    } else {
        f32x2 x[R][31];
#pragma unroll
        for (int tt = 0; tt < R; ++tt) {
#pragma unroll
            for (int j = 0; j < 30; ++j) x[tt][j] = *(const f32x2*)(state_conv + ((size_t)(r0 - NPROMPT + tt) * 30 + j) * CDIM + c0);
            x[tt][30] = *(const f32x2*)(V + (size_t)(r0 + tt) * CDIM + c0); }
#pragma unroll
        for (int tt = 0; tt < R; ++tt) o[tt] = cb;
#pragma unroll
        for (int j = 0; j < 31; ++j) { const f32x2 wj = wl[j * 512];
#pragma unroll
            for (int tt = 0; tt < R; ++tt) o[tt] += wj * x[tt][j]; }
    }
    constexpr int NV = 2 * R, SH = (NV == 32 ? 1 : NV == 4 ? 4 : NV == 2 ? 5 : -1); static_assert(SH > 0, "R is 16, 2 or 1");
    float p[NV];
#pragma unroll
    for (int tt = 0; tt < R; ++tt) { p[2 * tt] = o[tt][0] + o[tt][1]; p[2 * tt + 1] = o[tt][0] * o[tt][0] + o[tt][1] * o[tt][1]; }
#pragma unroll
    for (int h = NV / 2, off = 32; h >= 1; h >>= 1, off >>= 1) {
        const bool up = (lane & off) != 0;
#pragma unroll
        for (int i = 0; i < h; ++i) { const float keep = up ? p[i + h] : p[i], send = up ? p[i] : p[i + h]; p[i] = keep + __shfl_xor(send, off); }
    }
#pragma unroll
    for (int off = (1 << SH) >> 1; off >= 1; off >>= 1) p[0] += __shfl_xor(p[0], off);
    LAS float* red = (LAS float*)(lds + P4_RED); LAS f32x2* fin = (LAS f32x2*)(lds + P4_FIN);
    if ((lane & ((1 << SH) - 1)) == 0) red[wave * 32 + (lane >> SH)] = p[0];
    __syncthreads();
    if (tid < R) { float s1 = 0.f, s2 = 0.f;
#pragma unroll
        for (int wv = 0; wv < 8; ++wv) { s1 += red[wv * 32 + 2 * tid]; s2 += red[wv * 32 + 2 * tid + 1]; }
        const float mean = s1 * (1.0f / CDIM), var = s2 * (1.0f / CDIM) - mean * mean;
        fin[tid] = (f32x2){mean, __builtin_amdgcn_rsqf(var + EPS)}; }
    __syncthreads();
#pragma unroll
    for (int tt = 0; tt < R; ++tt) {
        const f32x2 mr = fin[tt];
        const float y0 = (o[tt][0] - mr[0]) * mr[1] * lg[0] + lb[0], y1 = (o[tt][1] - mr[0]) * mr[1] * lg[1] + lb[1];
        *(unsigned*)(MIX + (size_t)(r0 + tt) * D + c0) = cvt_pk_bf16(y0 * sigmoidf_fast(y0), y1 * sigmoidf_fast(y1));
    }
    __syncthreads();
}

__device__ __forceinline__ void p4_pool_unit(int r0, int g, const float* U, const float* state_pool, const bf16_t* PWT, const float* pscale, bf16_t* MIX, LAS unsigned char* lds, int tid, int lane, int wave) {
    const int cp = tid & 127, rq = __builtin_amdgcn_readfirstlane(tid >> 7), fr = lane & 15, fq = lane >> 4, ch = g * 256 + 2 * cp;
    bf16x8 bfr[2][8];
    const bf16_t* wb = PWT + ((size_t)(g * 256 + 32 * wave + fr) * 256 + fq * 8);
#define P4_LOAD_B() do { _Pragma("unroll") for (int nf = 0; nf < 2; ++nf) _Pragma("unroll") for (int ks = 0; ks < 8; ++ks) bfr[nf][ks] = *(const bf16x8*)(wb + (size_t)nf * 16 * 256 + ks * 32); } while (0)
    LAS unsigned char* arow = lds + (16 * rq) * 528 + 4 * cp;
    if (r0 < NPROMPT) {
        P4_LOAD_B();
        const int b = r0 >> 11, t0r = (r0 & (SEQ - 1)) + 16 * rq;
        if (g == 0) pool_d_prompt<2>(U, b, t0r, ch, arow); else if (g == 1) pool_d_prompt<4>(U, b, t0r, ch, arow);
        else if (g == 2) pool_d_prompt<8>(U, b, t0r, ch, arow); else pool_d_prompt<16>(U, b, t0r, ch, arow);
    } else {
        const int b0r = r0 - NPROMPT + 16 * rq;
        if (g == 0) pool_d_sample<2>(U, state_pool, b0r, ch, arow); else if (g == 1) pool_d_sample<4>(U, state_pool, b0r, ch, arow);
        else if (g == 2) pool_d_sample<8>(U, state_pool, b0r, ch, arow); else pool_d_sample<16>(U, state_pool, b0r, ch, arow);
        P4_LOAD_B();
    }
#undef P4_LOAD_B
    __syncthreads();
    f32x4 acc[4][2];
#pragma unroll
    for (int mf = 0; mf < 4; ++mf)
#pragma unroll
        for (int nf = 0; nf < 2; ++nf) acc[mf][nf] = (f32x4){0.f, 0.f, 0.f, 0.f};
#pragma unroll
    for (int ks = 0; ks < 8; ++ks)
#pragma unroll
        for (int mf = 0; mf < 4; ++mf) {
            const bf16x8 af = *(const LAS bf16x8*)(lds + (mf * 16 + fr) * 528 + ks * 64 + fq * 16);
#pragma unroll
            for (int nf = 0; nf < 2; ++nf) acc[mf][nf] = __builtin_amdgcn_mfma_f32_16x16x32_bf16(bfr[nf][ks], af, acc[mf][nf], 0, 0, 0);
        }
#pragma unroll
    for (int nf = 0; nf < 2; ++nf) { const int cg_ = g * 256 + 32 * wave + nf * 16 + 4 * fq; const f32x4 sc = *(const f32x4*)(pscale + cg_);
#pragma unroll
        for (int mf = 0; mf < 4; ++mf) { const f32x4 y = acc[mf][nf] * sc;
            u32x2 ov; ov.x = cvt_pk_bf16(y[0], y[1]); ov.y = cvt_pk_bf16(y[2], y[3]);
            *(u32x2*)(MIX + (size_t)(r0 + mf * 16 + fr) * D + CDIM + cg_) = ov; } }
    __syncthreads();
}

__device__ __forceinline__ void p4_copy_row(int it, const float* V, const float* U, const float* state_conv, const float* state_pool, float* out, int lane) {
    constexpr int R0 = NBATCH * 30, R1 = R0 + NSAMP * 30, R2 = R1 + NBATCH * 15;
    const float* src; float* dst;
    if (it < R0) { const int b = it / 30, i = it % 30; src = V + (size_t)(b * SEQ + SEQ - 30 + i) * CDIM; dst = out + OUT_NCP + (size_t)it * CDIM; }
    else if (it < R1) { const int q = it - R0, b = q / 30, i = q % 30; src = i < 29 ? state_conv + ((size_t)b * 30 + i + 1) * CDIM : V + (size_t)(NPROMPT + b) * CDIM; dst = out + OUT_NCS + (size_t)q * CDIM; }
    else if (it < R2) { const int q = it - R1, b = q / 15, i = q % 15; src = U + (size_t)(b * SEQ + SEQ - 15 + i) * PDIM; dst = out + OUT_NPP + (size_t)q * PDIM; }
    else { const int q = it - R2, b = q / 15, i = q % 15; src = i < 14 ? state_pool + ((size_t)b * 15 + i + 1) * PDIM : U + (size_t)(NPROMPT + b) * PDIM; dst = out + OUT_NPS + (size_t)q * PDIM; }
#pragma unroll
    for (int j = 0; j < 4; ++j) *(f32x4*)(dst + 4 * lane + 256 * j) = *(const f32x4*)(src + 4 * lane + 256 * j);
}
constexpr int P4_REP = (DUP_PHASE == 5 ? 2 : 1);
constexpr int P4_NCOPY = NBATCH * 30 + NSAMP * 30 + NBATCH * 15 + NSAMP * 15;
constexpr int P4_NCONV_S = NSAMP, P4_NCONV = P4_NCONV_S + NPROMPT / 16, P4_NPOOL = (NTOK / 64) * 4;

__device__ __forceinline__ void p4_mix(ArgsP ap, LAS unsigned char* lds, int tid, int G) {
    const int lane = tid & 63, wave = __builtin_amdgcn_readfirstlane(tid >> 6);
    unsigned char* ws = ARG_WS;
    const float* V = (const float*)(ws + WS_V); const float* U = (const float*)(ws + WS_U);
    bf16_t* MIX = (bf16_t*)(ws + WS_MIX); const bf16_t* PWT = (const bf16_t*)(ws + WS_PW);
    const float* state_conv = ARG_IN(2); const float* state_pool = ARG_IN(3);
    {
        const int c0 = 2 * tid;
        { const float* cw = ARG_IN(11);
            f32x4 t[16];
#pragma unroll
            for (int q = 0; q < 16; ++q) { const int i = tid + q * NTHREADS; t[q] = *(const f32x4*)(cw + 4 * (i < 31 * CDIM / 4 ? i : 0)); }
#pragma unroll
            for (int q = 0; q < 16; ++q) { const int i = tid + q * NTHREADS; if (i < 31 * CDIM / 4) *(LAS f32x4*)(lds + 16 * i) = t[q]; } }
        const f32x2 cb = *(const f32x2*)(ARG_IN(12) + c0), lg = *(const f32x2*)(ARG_IN(13) + c0), lb = *(const f32x2*)(ARG_IN(14) + c0);
        __syncthreads();
        for (int un_ = blockIdx.x; un_ < P4_NCONV * P4_REP; un_ += G) {
            const int un = un_ % P4_NCONV;
            if (un < P4_NCONV_S) p4_conv_unit<1>(NPROMPT + un, V, state_conv, MIX, cb, lg, lb, lds, tid, lane, wave);
            else p4_conv_unit<16>(16 * (un - P4_NCONV_S), V, state_conv, MIX, cb, lg, lb, lds, tid, lane, wave);
        }
        __syncthreads();
    }
    {
        const float* pscale = ARG_IN(16);
        for (int un_ = blockIdx.x; un_ < P4_NPOOL * P4_REP; un_ += G) { const int u2 = un_ % P4_NPOOL; p4_pool_unit(64 * (u2 >> 2), u2 & 3, U, state_pool, PWT, pscale, MIX, lds, tid, lane, wave); }
    }
    {
        const int gw = blockIdx.x * NWAVES + wave, NGW = G * NWAVES; float* out = ARG_OUT;
        for (int it = gw; it < P4_NCOPY; it += NGW) p4_copy_row(it, V, U, state_conv, state_pool, out, lane);
    }
}

__device__ __forceinline__ void p9_final(ArgsP ap, int tid, int G) {
    const float* ss = (const float*)(ARG_WS + WS_SS) + (size_t)4 * MP; const float* gn = ARG_IN(24); float* out = ARG_OUT;
    const size_t n4 = (size_t)NTOK * D / 4, GT = (size_t)G * NTHREADS;
    for (size_t i = (size_t)blockIdx.x * NTHREADS + tid; i < n4; i += GT) {
        const int r = (int)(i >> 9), c4 = (int)(i & 511);
        const float rs = __builtin_amdgcn_rsqf(ss[r] * (1.0f / D) + EPS);
        const f32x4 x = *(const f32x4*)(out + i * 4), gg = *(const f32x4*)(gn + 4 * c4);
        *(f32x4*)(out + i * 4) = x * rs * gg;
    }
}

constexpr int N_PHASES = 11;
__global__ void __launch_bounds__(NTHREADS, 2) fwd_kernel(Args args) {
    extern __shared__ __attribute__((aligned(16))) unsigned char lds_raw[];
    LAS unsigned char* lds = (LAS unsigned char*)lds_raw;
    volatile LAS unsigned* MISC = (volatile LAS unsigned*)(lds + MISC_OFF);
    ArgsP ap = (ArgsP)__builtin_amdgcn_kernarg_segment_ptr();
    const int tid = threadIdx.x, G = gridDim.x;
    unsigned char* ws = ARG_WS;
    if (tid < 64) MISC[tid] = 0u;
    __syncthreads();
    const int lo = ap->ph_lo, hi = ap->ph_hi;
    const bool one_launch = (hi - lo) > 1;
    XcdBarrier bar; bar.bar = (unsigned*)(ws + WS_CTL); bar.x = 0; bar.st = nullptr;
    if (one_launch) bar = xcd_barrier_post((unsigned*)(ws + WS_CTL), MISC + 8);
#define IN(k) (lo <= (k) && (k) < hi)
#define SEAM(k) do { if (IN(k) && IN((k) + 1)) xcd_barrier(bar); } while (0)

#define STAMP(k) do { if (TIMING_A >= 0 && blockIdx.x == 0 && tid == 0) MISC[16 + (k)] = (unsigned)__builtin_amdgcn_s_memrealtime(); } while (0)
    STAMP(0);
    float* SS = (float*)(ws + WS_SS);
    bf16_t* XNB = (bf16_t*)(ws + WS_XNB); bf16_t* ACT = (bf16_t*)(ws + WS_ACT); bf16_t* MIX = (bf16_t*)(ws + WS_MIX); bf16_t* PPB = (bf16_t*)(ws + WS_PP); bf16_t* PB = (bf16_t*)(ws + WS_PB);
    float* X = ARG_OUT;

    if (IN(0)) {
        p0_prologue(ap, lds, tid, G);
        if (IN(1)) { if (MK_N_LAUNCHES == 1) { cg::this_grid().sync(); } else xcd_barrier(bar); }
        STAMP(1);
    }
    if (IN(1)) {
        pg8::Gemm g{PB, (const bf16_t*)(ws + WS_WPP), MP, D, PLE}; pg8::StaticOrder S; S.init(MP, D, G, (int)blockIdx.x);
        pg8::Epi<pg8::EP_PP> E{}; E.outb = PPB;
        pg8::gemm_phase(lds, g, S, E);
        STAMP(2);
    }
    if (IN(2)) {
        pg8::Gemm g{XNB, (const bf16_t*)(ws + WS_W1IN), MP, 2 * DFF, D}; pg8::StaticOrder S; S.init(MP, 2 * DFF, G, (int)blockIdx.x);
        pg8::Epi<pg8::EP_SWIGLU> E{}; E.ss_in = SS; E.outb = ACT;
        pg8::gemm_phase(lds, g, S, E);
        SEAM(2); STAMP(3);
    }
    if (IN(3)) {
        pg8::Gemm g{ACT, (const bf16_t*)(ws + WS_W1OUT), MP, D, DFF}; pg8::StaticOrder S; S.init(MP, D, G, (int)blockIdx.x);
        pg8::Epi<pg8::EP_RESID> E{}; E.ss_out = SS + MP; E.res0 = ARG_IN(0); E.res1 = ARG_IN(1); E.outf = X; E.outb = XNB; E.scale = 0.5f;
        pg8::gemm_phase(lds, g, S, E);
        SEAM(3); STAMP(4);
    }
    if (IN(4)) {
        pg8::Gemm g{XNB, (const bf16_t*)(ws + WS_WIN), MP, 3072, D}; pg8::StaticOrder S; S.init(MP, 3072, G, (int)blockIdx.x);
        pg8::Epi<pg8::EP_WIN> E{}; E.ss_in = SS + MP; E.V = (float*)(ws + WS_V); E.U = (float*)(ws + WS_U);
        pg8::gemm_phase(lds, g, S, E);
        SEAM(4); STAMP(5);
    }
    if (IN(5)) {
        p4_mix(ap, lds, tid, G);
        SEAM(5); STAMP(6);
    }
    if (IN(6)) {
        pg8::Gemm g{MIX, (const bf16_t*)(ws + WS_WOUT), MP, D, D}; pg8::StaticOrder S; S.init(MP, D, G, (int)blockIdx.x);
        pg8::Epi<pg8::EP_RESID> E{}; E.ss_out = SS + 2 * MP; E.res0 = X; E.res1 = X + (size_t)NPROMPT * D; E.outf = X; E.outb = XNB; E.scale = 1.0f;
        pg8::gemm_phase(lds, g, S, E);
        SEAM(6); STAMP(7);
    }
    if (IN(7)) {
        pg8::Gemm g{XNB, (const bf16_t*)(ws + WS_W2IN), MP, 2 * DFF, D}; pg8::StaticOrder S; S.init(MP, 2 * DFF, G, (int)blockIdx.x);
        pg8::Epi<pg8::EP_SWIGLU> E{}; E.ss_in = SS + 2 * MP; E.outb = ACT;
        pg8::gemm_phase(lds, g, S, E);
        SEAM(7); STAMP(8);
    }
    if (IN(8)) {
        pg8::Gemm g{ACT, (const bf16_t*)(ws + WS_W2OUT), MP, D, DFF}; pg8::StaticOrder S; S.init(MP, D, G, (int)blockIdx.x);
        pg8::Epi<pg8::EP_RESID> E{}; E.ss_out = SS + 3 * MP; E.res0 = X; E.res1 = X + (size_t)NPROMPT * D; E.outf = X; E.outb = XNB; E.scale = 0.5f;
        pg8::gemm_phase(lds, g, S, E);
        SEAM(8); STAMP(9);
    }
    if (IN(9)) {
        pg8::Gemm g{XNB, (const bf16_t*)(ws + WS_WPG), MP, D, D}; pg8::StaticOrder S; S.init(MP, D, G, (int)blockIdx.x);
        pg8::Epi<pg8::EP_PLE> E{}; E.ss_in = SS + 3 * MP; E.ss_out = SS + 4 * MP; E.outf = X; E.pp = PPB;
        pg8::gemm_phase(lds, g, S, E);
        SEAM(9); STAMP(10);
    }
    if (IN(10)) p9_final(ap, tid, G);
    if (TIMING_A >= 0 && blockIdx.x == 0) {
        VM_WAIT(); __syncthreads();
        if (tid == 0) MISC[16 + 11] = (unsigned)__builtin_amdgcn_s_memrealtime();
        __syncthreads();
        const int ia = TIMING_A, ib = TIMING_B;
        const float da = (float)(MISC[16 + (ia == 11 ? 11 : ia + 1)] - MISC[16 + (ia == 11 ? 0 : ia)]) * 0.01f;
        const float db = (float)(MISC[16 + (ib == 11 ? 11 : ib + 1)] - MISC[16 + (ib == 11 ? 0 : ib)]) * 0.01f;
        const float f = 1.0f + sqrtf(db * 1e-3f);
        float* o5 = X + OUT_NPS;
        for (int i = tid; i < NSAMP * 15 * PDIM; i += NTHREADS) o5[i] *= f;
        if (tid == 0) X[0] = da;
    }
#undef IN
#undef SEAM
}

extern "C" void kernel_launch(void* const* d_in, const int* in_sizes, int n_in, void* d_out, int out_size, void* d_ws, size_t ws_size, hipStream_t stream) {
    static int grid = 0;
    if (grid == 0) {
        if (n_in != 25 || (size_t)out_size != OUT_END || ws_size < WS_END) {
            fprintf(stderr, "kernel_launch: built for 25 inputs, %zu outputs, >= %zu bytes of workspace; got n_in %d, out %d, ws %zu; nothing launched\n", (size_t)OUT_END, (size_t)WS_END, n_in, out_size, ws_size);
            grid = -1; return; }
        int dev = 0, cus = 0, per_cu = 0;
        if (hipGetDevice(&dev) != hipSuccess || hipDeviceGetAttribute(&cus, hipDeviceAttributeMultiprocessorCount, dev) != hipSuccess) { fprintf(stderr, "kernel_launch: device query failed\n"); grid = -1; return; }
        if (hipFuncSetAttribute((const void*)fwd_kernel, hipFuncAttributeMaxDynamicSharedMemorySize, LDS_BYTES) != hipSuccess) { fprintf(stderr, "kernel_launch: hipFuncSetAttribute failed\n"); grid = -1; return; }
        if (hipOccupancyMaxActiveBlocksPerMultiprocessor(&per_cu, (const void*)fwd_kernel, NTHREADS, LDS_BYTES) != hipSuccess || per_cu < 1) { fprintf(stderr, "kernel_launch: occupancy query says %d blocks per CU\n", per_cu); (void)hipGetLastError(); per_cu = 1; }
        grid = cus * 1;
        fprintf(stderr, "kernel_launch: %d CUs, occupancy query %d block(s)/CU, grid %d, LDS %d B, ws %zu B (need %zu)\n", cus, per_cu, grid, LDS_BYTES, ws_size, (size_t)WS_END);
    }
    if (grid < 0) return;
    if (hipMemsetAsync((char*)d_ws + WS_CTL, 0, CTL_BYTES, stream) != hipSuccess) { fprintf(stderr, "kernel_launch: memset failed\n"); return; }
    Args a{};
    for (int i = 0; i < 25; ++i) a.in[i] = (const float*)d_in[i];
    a.out = (float*)d_out; a.ws = (unsigned char*)d_ws;
#if MK_N_LAUNCHES == 1
    a.ph_lo = 0; a.ph_hi = N_PHASES;
    void* kargs[] = {&a};
    hipError_t e = hipLaunchCooperativeKernel((const void*)fwd_kernel, dim3(grid), dim3(NTHREADS), kargs, LDS_BYTES, stream);
    if (e != hipSuccess) fprintf(stderr, "kernel_launch: cooperative launch failed: %s (grid %d)\n", hipGetErrorString(e), grid);
#else
    for (int ph = 0; ph < N_PHASES; ++ph) {
        a.ph_lo = ph; a.ph_hi = ph + 1;
        hipLaunchKernelGGL(fwd_kernel, dim3(grid), dim3(NTHREADS), LDS_BYTES, stream, a);
        const hipError_t le = hipPeekAtLastError();
        if (le != hipSuccess) { fprintf(stderr, "kernel_launch: launch %d failed: %s\n", ph, hipGetErrorName(le)); break; }
    }
#endif
}
```

```cpp
#include <hip/hip_runtime.h>
#include <hip/hip_cooperative_groups.h>
#include <cstdio>
#include <cstdint>
namespace cg = cooperative_groups;

#ifndef PROF_CAT
#define PROF_CAT -1
#endif
#define PROF_KIND 0
#define PROF_MULT 8
#define LAS __attribute__((address_space(3)))
#define GAS __attribute__((address_space(1)))
typedef unsigned short bf16_t;
typedef short bf16x8 __attribute__((ext_vector_type(8)));
typedef float f32x4 __attribute__((ext_vector_type(4)));
typedef float f32x2 __attribute__((ext_vector_type(2)));
typedef unsigned u32x4 __attribute__((ext_vector_type(4)));
typedef unsigned u32x2 __attribute__((ext_vector_type(2)));

constexpr int D = 2048, DFF = 5632, NPROMPT = 8192, NSAMP = 128, NTOK = NPROMPT + NSAMP, MP = 8448  , SEQ = 2048;
constexpr int CDIM = 1024, PDIM = 1024, PLE = 256, NBATCH = 4, NRB = 33  ;
constexpr float EPS = 1e-6f;
constexpr int NWAVES = 8, NTHREADS = 512;

constexpr size_t WS_CTL = 0, CTL_BYTES = 65536;
constexpr size_t WS_W1IN = WS_CTL + CTL_BYTES;
constexpr size_t WS_W1OUT = WS_W1IN + (size_t)2 * DFF * D * 2;
constexpr size_t WS_W2IN = WS_W1OUT + (size_t)D * DFF * 2;
constexpr size_t WS_W2OUT = WS_W2IN + (size_t)2 * DFF * D * 2;
constexpr size_t WS_WIN = WS_W2OUT + (size_t)D * DFF * 2;
constexpr size_t WS_WOUT = WS_WIN + (size_t)3072 * D * 2;
constexpr size_t WS_WPG = WS_WOUT + (size_t)D * D * 2;
constexpr size_t WS_WPP = WS_WPG + (size_t)D * D * 2;
constexpr size_t WS_PW = WS_WPP + (size_t)D * PLE * 2;
constexpr size_t WS_XA = WS_PW + (size_t)4 * 256 * 256 * 2;
constexpr size_t WS_XB = WS_XA + (size_t)MP * D * 2;
constexpr size_t WS_ACT = WS_XB + (size_t)MP * D * 2;
constexpr size_t WS_V = WS_ACT + (size_t)MP * DFF * 2;
constexpr size_t WS_U = WS_V + (size_t)MP * CDIM * 4;
constexpr size_t WS_PB = WS_U + (size_t)MP * PDIM * 4;
constexpr size_t WS_SS = WS_PB + (size_t)MP * PLE * 2;
constexpr size_t WS_END = WS_SS + (size_t)5 * MP * 4;

constexpr size_t OUT_Y = 0, OUT_NCP = (size_t)NTOK * D, OUT_NCS = OUT_NCP + (size_t)NBATCH * 30 * CDIM, OUT_NPP = OUT_NCS + (size_t)NSAMP * 30 * CDIM,
                 OUT_NPS = OUT_NPP + (size_t)NBATCH * 15 * PDIM, OUT_END = OUT_NPS + (size_t)NSAMP * 15 * PDIM;

constexpr int CW_HEAD = 0, CW_FHEAD = 16, CW_TMO = 64, CW_FIN = 80, CW_PROF = 96  , CW_DONE = 128;
enum { SL_P1 = 0, SL_P2, SL_P3, SL_P4, SL_P5, SL_P6, SL_P7, SL_PP, SL_P8, SL_CONV  , N_SLOTS };
__host__ __device__ constexpr int cw_done(int slot, int pm) { return CW_DONE + (slot * 40 + pm) * 16; }
static_assert(cw_done(N_SLOTS, 0) * 4 <= (int)CTL_BYTES, "control words");

enum { K_P1 = 0, K_P2, K_P3, K_P5, K_P6, K_P7, K_PP, K_P8, T_P4  , T_P4COPY, T_P9 };
constexpr int P4_S_CONV = NSAMP / 4, P4_S_POOL = 8, P4_S = P4_S_CONV + P4_S_POOL;
constexpr int P4_RB = 32;
constexpr int P4_NCOPYROWS = NBATCH * 30 + NSAMP * 30 + NBATCH * 15 + NSAMP * 15, P4_COPY = (P4_NCOPYROWS + 63) / 64;
struct Seg { int type, pm0, npm; };
constexpr int NSEG = 27;
constexpr Seg SEGS[NSEG] = {
    {K_P1, 32, 1}, {K_P1, 0, 8}, {K_P2, 32, 1}, {K_P1, 8, 16}, {K_P3, 32, 1}, {K_P1, 24, 8}, {T_P4, 32, 1},
    {K_P2, 0, 32}, {K_P3, 0, 16}, {K_P5, 32, 1}, {K_P3, 16, 16}, {T_P4, 0, 16}, {K_P6, 32, 1}, {T_P4, 16, 16}, {T_P4COPY, 0, 0},
    {K_P5, 0, 32}, {K_P6, 0, 8}, {K_P7, 32, 1}, {K_PP, 32, 1}, {K_P6, 8, 16}, {K_P8, 32, 1}, {K_P6, 24, 8}, {T_P9, 32, 1},
    {K_P7, 0, 32}, {K_PP, 0, 32}, {K_P8, 0, 32}, {T_P9, 0, 32}};
__host__ __device__ constexpr int kind_ncol(int k) { return (k == K_P1 || k == K_P6) ? 44 : k == K_P3 ? 12 : 8; }
__host__ __device__ constexpr int seg_count(int s) {
    return SEGS[s].type <= K_P8 ? SEGS[s].npm * kind_ncol(SEGS[s].type) : SEGS[s].type == T_P4 ? (SEGS[s].pm0 == 32 ? P4_S : SEGS[s].npm * P4_RB) : SEGS[s].type == T_P4COPY ? P4_COPY : (SEGS[s].pm0 == 32 ? NSAMP / 16 : SEGS[s].npm * 16); }
__host__ __device__ constexpr int seg_start(int s) { int t = 0; for (int i = 0; i < s; ++i) t += seg_count(i); return t; }
constexpr int IT_END = seg_start(NSEG);
static_assert(IT_END == 33 * (44 + 8 + 12 + 8 + 44 + 8 + 8 + 8) + P4_S + 32 * P4_RB + P4_COPY + NTOK / 16, "every item exactly once");
constexpr unsigned NEED_P4_RB = P4_RB, NEED_P4_S = P4_S;

enum { CM_W1OUT = 0, CM_WIN, CM_PW, CM_WOUT, CM_W2IN, CM_W2OUT, CM_WPP, CM_WPG, N_CM };
__host__ __device__ constexpr int cm_items(int m) { return m == CM_W1OUT ? 0   : m == CM_WIN ? (D / 64) * (3072 / 256) : m == CM_PW ? 4 * (256 / 64) : m == CM_WOUT ? (D / 64) * (D / 256) : m == CM_W2IN ? (D / 64) * (2 * DFF / 256) : m == CM_W2OUT ? (DFF / 64) * (D / 256) : m == CM_WPP ? (PLE / 64) * (D / 256) : (D / 64) * (D / 256); }
__host__ __device__ constexpr int cm_start(int m) { int s = 0; for (int i = 0; i < m; ++i) s += cm_items(i); return s; }
constexpr int NFILL = cm_start(N_CM);

__device__ __forceinline__ unsigned cvt_pk_bf16(float lo, float hi) { unsigned r; asm volatile("v_cvt_pk_bf16_f32 %0, %1, %2" : "=v"(r) : "v"(lo), "v"(hi)); return r; }
__device__ __forceinline__ float bf_lo(unsigned w) { return __uint_as_float(w << 16); }
__device__ __forceinline__ float bf_hi(unsigned w) { return __uint_as_float(w & 0xffff0000u); }
__device__ __forceinline__ float sigmoidf_fast(float x) { return __builtin_amdgcn_rcpf(1.0f + __builtin_amdgcn_exp2f(-1.44269504089f * x)); }
__device__ __forceinline__ float wave_sum(float v) {
#pragma unroll
    for (int o = 1; o < 64; o <<= 1) v += __shfl_xor(v, o);
    return v;
}
#define LDS_WAIT() asm volatile("s_waitcnt lgkmcnt(0)" ::: "memory")
#define VM_WAIT() asm volatile("s_waitcnt vmcnt(0)" ::: "memory")
#define RLX_AGENT __ATOMIC_RELAXED, __HIP_MEMORY_SCOPE_AGENT
__device__ __forceinline__ void st16_wt(void* p, u32x4 v) { asm volatile("global_store_dwordx4 %0, %1, off sc1\n\ts_nop 1" :: "v"(p), "v"(v) : "memory"); }
__device__ __forceinline__ void st16_wt(void* p, f32x4 v) { asm volatile("global_store_dwordx4 %0, %1, off sc1\n\ts_nop 1" :: "v"(p), "v"(v) : "memory"); }
__device__ __forceinline__ void st8_wt(void* p, u32x2 v) { __hip_atomic_store((unsigned long long*)p, ((unsigned long long)v.y << 32) | v.x, RLX_AGENT); }
__device__ __forceinline__ void st4_wt(void* p, unsigned v) { __hip_atomic_store((unsigned*)p, v, RLX_AGENT); }
__device__ __forceinline__ f32x2 ld8_sc1(const float* p) { const unsigned long long w = __hip_atomic_load((const unsigned long long*)p, RLX_AGENT); return (f32x2){__uint_as_float((unsigned)w), __uint_as_float((unsigned)(w >> 32))}; }
__device__ __forceinline__ unsigned ld_cnt(const unsigned* p) { return __hip_atomic_load(p, RLX_AGENT); }
__device__ __forceinline__ void wait_ge(unsigned* ctl, int word, unsigned need) {
    unsigned sp = 0;
    while (ld_cnt(ctl + word) < need) {
        __builtin_amdgcn_s_sleep(2);
        if ((++sp & 255u) == 0u) { if (ld_cnt(ctl + CW_TMO) != 0u) break; if (sp > (1u << 17)) { __hip_atomic_store(ctl + CW_TMO, 1u, RLX_AGENT); break; } }
    }
}

namespace pg8 {
constexpr int BM = 256, BK = 64, HALF = 128, HTB = HALF * BK * 2  , STAGE_BYTES = 8 * HTB;
__host__ __device__ __forceinline__ int lds_byte(int r, int c) { const int st = (r >> 4) * 2 + (c >> 5), rr = r & 15, cc = c & 31, ob = rr * 64 + cc * 2; return st * 1024 + (ob ^ (((ob >> 9) & 1) << 5)); }
__host__ __device__ __forceinline__ void stage_rc(int b, int& R, int& C) { const int st = b / 1024, sb = b % 1024, swz = sb ^ (((sb >> 9) & 1) << 5); R = (st >> 1) * 16 + swz / 64; C = (st & 1) * 32 + (swz % 64) / 2; }
__host__ __device__ __forceinline__ int perm32(int rho) { const int n = rho >> 4, i = rho & 15; return 8 * (i >> 2) + 4 * n + (i & 3); }

struct Unit { int kind, pm, pn; };
__device__ __forceinline__ Unit decode(int it) {
    int s = 0, base = 0;
#pragma unroll
    for (int i = 1; i < NSEG; ++i) { if (it >= seg_start(i)) { s = i; base = seg_start(i); } }
    int type = 0, pm0 = 0;
#pragma unroll
    for (int i = 0; i < NSEG; ++i) { if (s == i) { type = SEGS[i].type; pm0 = SEGS[i].pm0; } }
    const int j = it - base;
    Unit u; u.kind = type;
    if (type <= K_P8) {
        const int nN = (type == K_P1 || type == K_P6) ? 44 : type == K_P3 ? 12 : 8;
        if (pm0 == 32) { u.pm = 32; u.pn = j; }
        else if (nN == 8) { u.pm = pm0 + (j >> 3); u.pn = j & 7; }
        else { const int g = j / (8 * nN), w = j - g * 8 * nN; u.pn = w >> 3; u.pm = pm0 + g * 8 + (w & 7); }
    } else if (type == T_P4) { if (pm0 == 32) { u.pm = 32; u.pn = j; } else { u.pm = pm0 + (j >> 5); u.pn = j & 31; } }
    else if (type == T_P4COPY) { u.pm = 0; u.pn = j; }
    else { if (pm0 == 32) { u.pm = 32; u.pn = j; } else { u.pm = pm0 + (j >> 4); u.pn = j & 15; } }
    return u;
}
__device__ __forceinline__ void kind_operands(int kind, unsigned char* ws, const char*& A, const char*& Bt, int& K) {
    switch (kind) {
        case K_P1: A = (const char*)(ws + WS_XA); Bt = (const char*)(ws + WS_W1IN); K = D; break;
        case K_P2: A = (const char*)(ws + WS_ACT); Bt = (const char*)(ws + WS_W1OUT); K = DFF; break;
        case K_P3: A = (const char*)(ws + WS_XB); Bt = (const char*)(ws + WS_WIN); K = D; break;
        case K_P5: A = (const char*)(ws + WS_XA); Bt = (const char*)(ws + WS_WOUT); K = D; break;
        case K_P6: A = (const char*)(ws + WS_XB); Bt = (const char*)(ws + WS_W2IN); K = D; break;
        case K_P7: A = (const char*)(ws + WS_ACT); Bt = (const char*)(ws + WS_W2OUT); K = DFF; break;
        case K_PP: A = (const char*)(ws + WS_PB); Bt = (const char*)(ws + WS_WPP); K = PLE; break;
        default:   A = (const char*)(ws + WS_XA); Bt = (const char*)(ws + WS_WPG); K = D; break;
    }
}
__device__ __forceinline__ void wait_deps(const Unit& u, unsigned* ctl) {
    switch (u.kind) {
        case K_P1: break;
        case K_P2: wait_ge(ctl, cw_done(SL_P1, u.pm), 44 * 8); break;
        case K_P3: wait_ge(ctl, cw_done(SL_P2, u.pm), 8 * 8); break;
        case K_P5: wait_ge(ctl, cw_done(SL_P4, u.pm), u.pm == 32 ? NEED_P4_S : NEED_P4_RB); break;
        case K_P6: wait_ge(ctl, cw_done(SL_P5, u.pm), 8 * 8); break;
        case K_P7: wait_ge(ctl, cw_done(SL_P6, u.pm), 44 * 8); break;
        case K_PP: wait_ge(ctl, cw_done(SL_P6, u.pm), 44 * 8); break;
        default:   wait_ge(ctl, cw_done(SL_P7, u.pm), 8 * 8); wait_ge(ctl, cw_done(SL_PP, u.pm), 8 * 8); break;
    }
}
__device__ __forceinline__ bool conv_ready(unsigned* ctl, int m) { return ld_cnt(ctl + cw_done(SL_CONV, m)) >= (unsigned)cm_items(m); }
__device__ __forceinline__ bool deps_ready(const Unit& u, unsigned* ctl) {
    switch (u.kind) {
        case K_P1: return true;
        case K_P2: return ld_cnt(ctl + cw_done(SL_P1, u.pm)) >= 44u * 8u && conv_ready(ctl, CM_W1OUT);
        case K_P3: return ld_cnt(ctl + cw_done(SL_P2, u.pm)) >= 8u * 8u && conv_ready(ctl, CM_WIN);
        case K_P5: return ld_cnt(ctl + cw_done(SL_P4, u.pm)) >= (u.pm == 32 ? NEED_P4_S : NEED_P4_RB) && conv_ready(ctl, CM_WOUT);
        case K_P6: return ld_cnt(ctl + cw_done(SL_P5, u.pm)) >= 8u * 8u && conv_ready(ctl, CM_W2IN);
        case K_P7: return ld_cnt(ctl + cw_done(SL_P6, u.pm)) >= 44u * 8u && conv_ready(ctl, CM_W2OUT);
        case K_PP: return ld_cnt(ctl + cw_done(SL_P6, u.pm)) >= 44u * 8u && conv_ready(ctl, CM_WPP);
        default:   return ld_cnt(ctl + cw_done(SL_P7, u.pm)) >= 8u * 8u && ld_cnt(ctl + cw_done(SL_PP, u.pm)) >= 8u * 8u && conv_ready(ctl, CM_WPG);
    }
}
__device__ __forceinline__ int done_slot(int kind) { return kind == K_P1 ? SL_P1 : kind == K_P2 ? SL_P2 : kind == K_P3 ? SL_P3 : kind == K_P5 ? SL_P5 : kind == K_P6 ? SL_P6 : kind == K_P7 ? SL_P7 : kind == K_PP ? SL_PP : SL_P8; }

typedef __amdgpu_buffer_rsrc_t rsrc_t;
__device__ __forceinline__ rsrc_t mk_rsrc(const void* p, unsigned bytes) { return __builtin_amdgcn_make_buffer_rsrc((void*)p, (short)0, (int)bytes, 0x00020000); }
__device__ __forceinline__ void bst16(rsrc_t r, unsigned off, u32x4 v) { __builtin_amdgcn_raw_buffer_store_b128(v, r, (int)off, 0, 16); }
__device__ __forceinline__ void bst16(rsrc_t r, unsigned off, f32x4 v) { __builtin_amdgcn_raw_buffer_store_b128(__builtin_bit_cast(u32x4, v), r, (int)off, 0, 16); }
template <int AUX> __device__ __forceinline__ f32x4 bld16f(rsrc_t r, unsigned off) { return __builtin_bit_cast(f32x4, __builtin_amdgcn_raw_buffer_load_b128(r, (int)off, 0, AUX)); }
template <int AUX> __device__ __forceinline__ u32x4 bld16u(rsrc_t r, unsigned off) { return __builtin_amdgcn_raw_buffer_load_b128(r, (int)off, 0, AUX); }
__device__ __forceinline__ u32x4 pack8(const f32x4& a, const f32x4& b) { u32x4 w; w.x = cvt_pk_bf16(a[0], a[1]); w.y = cvt_pk_bf16(a[2], a[3]); w.z = cvt_pk_bf16(b[0], b[1]); w.w = cvt_pk_bf16(b[2], b[3]); return w; }
__device__ __forceinline__ float sumsq8(const f32x4& a, const f32x4& b) { return (a[0] * a[0] + a[1] * a[1]) + (a[2] * a[2] + a[3] * a[3]) + (b[0] * b[0] + b[1] * b[1]) + (b[2] * b[2] + b[3] * b[3]); }

struct EpiCtx { int pm, pn, wr, wc, fr, fq; };
__device__ __forceinline__ void load_rs(const float* ss, const EpiCtx& c, float (&rs)[2][4]) {
    float s[2][4];
#pragma unroll
    for (int ai = 0; ai < 2; ++ai)
#pragma unroll
        for (int m = 0; m < 4; ++m) { const int r = c.pm * BM + ai * HALF + c.wr * 64 + m * 16 + c.fr; s[ai][m] = __hip_atomic_load(ss + (r < NTOK ? r : 0), RLX_AGENT); }
#pragma unroll
    for (int ai = 0; ai < 2; ++ai)
#pragma unroll
        for (int m = 0; m < 4; ++m) rs[ai][m] = __builtin_amdgcn_rsqf(s[ai][m] * (1.0f / D) + EPS);
}
#define EPI_ROWS_BEGIN  _Pragma("unroll") for (int ai = 0; ai < 2; ++ai) { if (c.pm * BM + ai * HALF >= NTOK) continue; _Pragma("unroll") for (int m = 0; m < 4; ++m) { const int r = c.pm * BM + ai * HALF + c.wr * 64 + m * 16 + c.fr;
#define EPI_ROWS_END } }

__device__ __forceinline__ void epi_swiglu(const f32x4 (&acc)[2][2][4][2], const EpiCtx& c, const float* ss_in, bf16_t* act) {
    float rs[2][4]; load_rs(ss_in, c, rs);
    const rsrc_t ro = mk_rsrc(act, (unsigned)((size_t)MP * DFF * 2));
    const int cw = c.wc * 32 + 8 * c.fq;
    EPI_ROWS_BEGIN
        f32x4 a[2];
#pragma unroll
        for (int n = 0; n < 2; ++n)
#pragma unroll
            for (int j = 0; j < 4; ++j) { const float g = acc[ai][0][m][n][j] * rs[ai][m], up = acc[ai][1][m][n][j] * rs[ai][m]; a[n][j] = g * sigmoidf_fast(g) * up; }
        bst16(ro, (unsigned)(((size_t)r * DFF + c.pn * HALF + cw) * 2), pack8(a[0], a[1]));
    EPI_ROWS_END
}
template <bool RES_INPUT> __device__ __forceinline__ void epi_resid(const f32x4 (&acc)[2][2][4][2], const EpiCtx& c, const float* res0, const float* res1, float* X, bf16_t* xb, float* ss_out, float scale) {
    const rsrc_t rx = mk_rsrc(X, (unsigned)((size_t)NTOK * D * 4)), rb = mk_rsrc(xb, (unsigned)((size_t)MP * D * 2));
    const rsrc_t rr = RES_INPUT ? (c.pm < NPROMPT / BM ? mk_rsrc(res0, (unsigned)((size_t)NPROMPT * D * 4)) : mk_rsrc(res1, (unsigned)((size_t)NSAMP * D * 4))) : rx;
    const int col = c.pn * BM + c.wc * 32 + 8 * c.fq;
    const int rsub = (RES_INPUT && c.pm >= NPROMPT / BM) ? NPROMPT : 0;
    constexpr int AUX = RES_INPUT ? 0 : 16;
    const int nai = (c.pm * BM + HALF >= NTOK) ? 1 : 2;
    f32x4 xc[2][2], xn[2][2];
    { const int r = c.pm * BM + c.wr * 64 + c.fr - rsub; const unsigned o = (unsigned)(((size_t)r * D + col) * 4);
#pragma unroll
      for (int bj = 0; bj < 2; ++bj) { xc[bj][0] = bld16f<AUX>(rr, o + bj * HALF * 4); xc[bj][1] = bld16f<AUX>(rr, o + bj * HALF * 4 + 16); } }
#pragma unroll
    for (int ai = 0; ai < 2; ++ai) {
        if (ai >= nai) continue;
#pragma unroll
        for (int m = 0; m < 4; ++m) {
            const int r = c.pm * BM + ai * HALF + c.wr * 64 + m * 16 + c.fr;
            const int q = ai * 4 + m + 1;
            if (q < nai * 4) { const int r2 = c.pm * BM + (q >> 2) * HALF + c.wr * 64 + (q & 3) * 16 + c.fr - rsub; const unsigned o = (unsigned)(((size_t)r2 * D + col) * 4);
#pragma unroll
                for (int bj = 0; bj < 2; ++bj) { xn[bj][0] = bld16f<AUX>(rr, o + bj * HALF * 4); xn[bj][1] = bld16f<AUX>(rr, o + bj * HALF * 4 + 16); } }
            float sq = 0.f;
            const unsigned of = (unsigned)(((size_t)r * D + col) * 4), ob = (unsigned)(((size_t)r * D + col) * 2);
#pragma unroll
            for (int bj = 0; bj < 2; ++bj) {
                const f32x4 y0 = xc[bj][0] + acc[ai][bj][m][0] * scale, y1 = xc[bj][1] + acc[ai][bj][m][1] * scale;
                bst16(rx, of + bj * HALF * 4, y0); bst16(rx, of + bj * HALF * 4 + 16, y1);
                bst16(rb, ob + bj * HALF * 2, pack8(y0, y1));
                sq += sumsq8(y0, y1);
            }
            sq += __shfl_xor(sq, 16); sq += __shfl_xor(sq, 32);
            if (c.fq == 0) unsafeAtomicAdd(ss_out + r, sq);
#pragma unroll
            for (int bj = 0; bj < 2; ++bj) { xc[bj][0] = xn[bj][0]; xc[bj][1] = xn[bj][1]; }
        }
    }
}
__device__ __forceinline__ void epi_win(const f32x4 (&acc)[2][2][4][2], const EpiCtx& c, const float* ss_in, float* V, float* U) {
    float rs[2][4]; load_rs(ss_in, c, rs);
    const rsrc_t rv = mk_rsrc(V, (unsigned)((size_t)MP * CDIM * 4)), ru = mk_rsrc(U, (unsigned)((size_t)MP * PDIM * 4));
    const int cw = c.wc * 32 + 8 * c.fq;
    EPI_ROWS_BEGIN
        if (c.pn < 8) {
            const unsigned o = (unsigned)(((size_t)r * CDIM + c.pn * HALF + cw) * 4);
#pragma unroll
            for (int n = 0; n < 2; ++n) { f32x4 v;
#pragma unroll
                for (int j = 0; j < 4; ++j) v[j] = (acc[ai][0][m][n][j] * rs[ai][m]) * sigmoidf_fast(acc[ai][1][m][n][j] * rs[ai][m]);
                bst16(rv, o + 16 * n, v); }
        } else {
            const unsigned o = (unsigned)(((size_t)r * PDIM + (c.pn - 8) * BM + cw) * 4);
#pragma unroll
            for (int bj = 0; bj < 2; ++bj)
#pragma unroll
                for (int n = 0; n < 2; ++n) bst16(ru, o + bj * HALF * 4 + 16 * n, acc[ai][bj][m][n] * rs[ai][m]);
        }
    EPI_ROWS_END
}
__device__ __forceinline__ void epi_pp(const f32x4 (&acc)[2][2][4][2], const EpiCtx& c, bf16_t* ppo) {
    const rsrc_t ro = mk_rsrc(ppo, (unsigned)((size_t)MP * D * 2));
    const int col = c.pn * BM + c.wc * 32 + 8 * c.fq;
    EPI_ROWS_BEGIN
#pragma unroll
        for (int bj = 0; bj < 2; ++bj) bst16(ro, (unsigned)(((size_t)r * D + col + bj * HALF) * 2), pack8(acc[ai][bj][m][0], acc[ai][bj][m][1]));
    EPI_ROWS_END
}
__device__ __forceinline__ void epi_ple(const f32x4 (&acc)[2][2][4][2], const EpiCtx& c, const float* ss_in, float* X, const bf16_t* ppi, float* ss_out) {
    float rs[2][4]; load_rs(ss_in, c, rs);
    const rsrc_t rx = mk_rsrc(X, (unsigned)((size_t)NTOK * D * 4)), rp = mk_rsrc(ppi, (unsigned)((size_t)MP * D * 2));
    const int col = c.pn * BM + c.wc * 32 + 8 * c.fq;
    const int nai = (c.pm * BM + HALF >= NTOK) ? 1 : 2;
    f32x4 xc[2][2], xn[2][2]; u32x4 pc[2], pn_[2];
    { const int r = c.pm * BM + c.wr * 64 + c.fr; const unsigned o = (unsigned)(((size_t)r * D + col) * 4), o2 = (unsigned)(((size_t)r * D + col) * 2);
#pragma unroll
      for (int bj = 0; bj < 2; ++bj) { xc[bj][0] = bld16f<16>(rx, o + bj * HALF * 4); xc[bj][1] = bld16f<16>(rx, o + bj * HALF * 4 + 16); pc[bj] = bld16u<16>(rp, o2 + bj * HALF * 2); } }
#pragma unroll
    for (int ai = 0; ai < 2; ++ai) {
        if (ai >= nai) continue;
#pragma unroll
        for (int m = 0; m < 4; ++m) {
            const int r = c.pm * BM + ai * HALF + c.wr * 64 + m * 16 + c.fr;
            const int q = ai * 4 + m + 1;
            if (q < nai * 4) { const int r2 = c.pm * BM + (q >> 2) * HALF + c.wr * 64 + (q & 3) * 16 + c.fr; const unsigned o = (unsigned)(((size_t)r2 * D + col) * 4), o2 = (unsigned)(((size_t)r2 * D + col) * 2);
#pragma unroll
                for (int bj = 0; bj < 2; ++bj) { xn[bj][0] = bld16f<16>(rx, o + bj * HALF * 4); xn[bj][1] = bld16f<16>(rx, o + bj * HALF * 4 + 16); pn_[bj] = bld16u<16>(rp, o2 + bj * HALF * 2); } }
            float sq = 0.f;
            const unsigned of = (unsigned)(((size_t)r * D + col) * 4);
#pragma unroll
            for (int bj = 0; bj < 2; ++bj) {
                const u32x4 pw = pc[bj];
                const f32x4 p0 = {bf_lo(pw.x), bf_hi(pw.x), bf_lo(pw.y), bf_hi(pw.y)}, p1 = {bf_lo(pw.z), bf_hi(pw.z), bf_lo(pw.w), bf_hi(pw.w)};
                f32x4 y0, y1;
#pragma unroll
                for (int j = 0; j < 4; ++j) { y0[j] = xc[bj][0][j] + sigmoidf_fast(acc[ai][bj][m][0][j] * rs[ai][m]) * p0[j]; y1[j] = xc[bj][1][j] + sigmoidf_fast(acc[ai][bj][m][1][j] * rs[ai][m]) * p1[j]; }
                bst16(rx, of + bj * HALF * 4, y0); bst16(rx, of + bj * HALF * 4 + 16, y1);
                sq += sumsq8(y0, y1);
            }
            sq += __shfl_xor(sq, 16); sq += __shfl_xor(sq, 32);
            if (c.fq == 0) unsafeAtomicAdd(ss_out + r, sq);
#pragma unroll
            for (int bj = 0; bj < 2; ++bj) { xc[bj][0] = xn[bj][0]; xc[bj][1] = xn[bj][1]; pc[bj] = pn_[bj]; }
        }
    }
}

__device__ __forceinline__ void run_epilogue(const f32x4 (&acc)[2][2][4][2], const Unit& u, int wr, int wc, int fr, int fq, unsigned char* ws, const float* xin0, const float* xin1, float* X) {
    float* SS = (float*)(ws + WS_SS);
    bf16_t* XA = (bf16_t*)(ws + WS_XA); bf16_t* XB = (bf16_t*)(ws + WS_XB); bf16_t* ACT = (bf16_t*)(ws + WS_ACT);
    const EpiCtx c{u.pm, u.pn, wr, wc, fr, fq};
    switch (u.kind) {
        case K_P1: epi_swiglu(acc, c, SS, ACT); break;
        case K_P6: epi_swiglu(acc, c, SS + 2 * MP, ACT); break;
        case K_P2: epi_resid<true>(acc, c, xin0, xin1, X, XB, SS + MP, 0.5f); break;
        case K_P5: epi_resid<false>(acc, c, nullptr, nullptr, X, XB, SS + 2 * MP, 1.0f); break;
        case K_P7: epi_resid<false>(acc, c, nullptr, nullptr, X, XA, SS + 3 * MP, 0.5f); break;
        case K_P3: epi_win(acc, c, SS + MP, (float*)(ws + WS_V), (float*)(ws + WS_U)); break;
        case K_PP: epi_pp(acc, c, XB); break;
        default:   epi_ple(acc, c, SS + 3 * MP, X, XB, SS + 4 * MP); break;
    }
}

#define PROF_NOW() ((unsigned)__builtin_amdgcn_s_memrealtime())
#define PROF_BEGIN(MW, k) do { if (PROF_CAT == (k) && threadIdx.x == 0) (MW)[32] = PROF_NOW(); } while (0)
#define PROF_END(MW, k) do { if (PROF_CAT == (k) && threadIdx.x == 0) (MW)[16] += PROF_NOW() - (MW)[32]; } while (0)
__device__ __forceinline__ int gemm_stream(LAS unsigned char* lds, volatile LAS unsigned* misc, unsigned char* ws, unsigned* ctl, const float* xin0, const float* xin1, float* X, int ticket) {
    int tid_ = threadIdx.x; asm volatile("" : "+v"(tid_));
    const int tid = tid_, wid = __builtin_amdgcn_readfirstlane(tid >> 6), lane = tid & 63, wr = wid >> 2, wc = wid & 3, fr = lane & 15, fq = lane >> 4;
    unsigned RvA[2], RvB[2], Cv[2];
#pragma unroll
    for (int i = 0; i < 2; ++i) { int R, C; stage_rc(tid * 16 + i * 8192, R, C); RvA[i] = (unsigned)R; RvB[i] = (unsigned)((R & ~31) + perm32(R & 31)); Cv[i] = (unsigned)C * 2u; }
    const unsigned ldsw = (unsigned)wid * 1024u;
    const int aoff = lds_byte(wr * 64 + fr, fq * 8), boff = lds_byte(wc * 32 + fr, fq * 8);
#define PG8_SA(b, h) (((b) * 2 + (h)) * HTB)
#define PG8_SB(b, h) ((4 + (b) * 2 + (h)) * HTB)
#define PG8_STAGE_A(bufoff, gbase, kbv) do { _Pragma("unroll") for (int _i = 0; _i < 2; ++_i) \
        __builtin_amdgcn_global_load_lds((const unsigned*)((const char*)(gbase) + (RvA[_i] * (unsigned)(kbv) + Cv[_i])), (LAS unsigned*)(lds + (bufoff) + ldsw + _i * 8192), 16, 0, 16); } while (0)
#define PG8_STAGE_B(bufoff, gbase, kbv) do { _Pragma("unroll") for (int _i = 0; _i < 2; ++_i) \
        __builtin_amdgcn_global_load_lds((const unsigned*)((const char*)(gbase) + (RvB[_i] * (unsigned)(kbv) + Cv[_i])), (LAS unsigned*)(lds + (bufoff) + ldsw + _i * 8192), 16, 0, 0); } while (0)
#define PG8_LDA(dst, b, h) do { _Pragma("unroll") for (int m = 0; m < 4; ++m) _Pragma("unroll") for (int k = 0; k < 2; ++k) dst[m][k] = *(const LAS bf16x8*)(lds + PG8_SA(b, h) + aoff + m * 2048 + k * 1024); } while (0)
#define PG8_LDB(dst, b, h) do { _Pragma("unroll") for (int n = 0; n < 2; ++n) _Pragma("unroll") for (int k = 0; k < 2; ++k) dst[n][k] = *(const LAS bf16x8*)(lds + PG8_SB(b, h) + boff + n * 2048 + k * 1024); } while (0)
#define PG8_MMA(ai, bj, At, Bt) do { __builtin_amdgcn_s_setprio(1); _Pragma("unroll") for (int m = 0; m < 4; ++m) _Pragma("unroll") for (int n = 0; n < 2; ++n) _Pragma("unroll") for (int k = 0; k < 2; ++k) \
        acc[ai][bj][m][n] = __builtin_amdgcn_mfma_f32_16x16x32_bf16(Bt[n][k], At[m][k], acc[ai][bj][m][n], 0, 0, 0); __builtin_amdgcn_s_setprio(0); } while (0)
#define PG8_WAIT_V(n) asm volatile("s_waitcnt vmcnt(" #n ")" ::: "memory")
#define PG8_WAIT_L(n) asm volatile("s_waitcnt lgkmcnt(" #n ")" ::: "memory")
#define PG8_BAR __builtin_amdgcn_s_barrier()
#define PG8_SCHED __builtin_amdgcn_sched_barrier(0)
    PROF_BEGIN(misc, 4);
    Unit cur = decode(ticket), nxt = cur;
    __syncthreads();
    const char *cA, *cB; int K; kind_operands(cur.kind, ws, cA, cB, K);
    unsigned kb = (unsigned)K * 2u; int nt = K / BK;
    cA += (size_t)cur.pm * 256 * kb; cB += (size_t)cur.pn * 256 * kb;
    f32x4 acc[2][2][4][2];
#pragma unroll
    for (int a = 0; a < 2; ++a)
#pragma unroll
        for (int b = 0; b < 2; ++b)
#pragma unroll
            for (int m = 0; m < 4; ++m)
#pragma unroll
                for (int n = 0; n < 2; ++n) acc[a][b][m][n] = (f32x4){0.f, 0.f, 0.f, 0.f};
    bf16x8 At[4][2], B0[2][2], B1[2][2];
    {
        const size_t hs = (size_t)HALF * kb;
        PG8_STAGE_B(PG8_SB(0, 0), cB, kb); PG8_STAGE_B(PG8_SB(0, 1), cB + hs, kb); PG8_STAGE_A(PG8_SA(0, 0), cA, kb); PG8_STAGE_A(PG8_SA(0, 1), cA + hs, kb);
        if (wr == 1) PG8_BAR;
        PG8_WAIT_V(2); PG8_BAR;
        PG8_STAGE_B(PG8_SB(1, 0), cB + 128, kb); PG8_STAGE_A(PG8_SA(1, 0), cA + 128, kb); PG8_STAGE_B(PG8_SB(1, 1), cB + hs + 128, kb);
        PG8_WAIT_V(6); PG8_BAR;
    }
    int next_ticket = ticket;
    PROF_END(misc, 4);
    PROF_BEGIN(misc, 2);
    if ((PROF_CAT == 14 || PROF_CAT == 15) && threadIdx.x == 0) misc[34] = PROF_NOW();
    for (;;) {
        unsigned tk = 0u;
        bool has_next = false; const char* nA = cA; const char* nB = cB; unsigned kbn = kb;
#pragma nounroll
        for (int t = 0; t < nt; t += 2) {
            const bool last = (t == nt - 2);
            if (t == (nt >= 4 ? nt - 4 : 0) && tid == 0) tk = __hip_atomic_fetch_add(ctl + CW_HEAD, 1u, RLX_AGENT);
            if (last) {
                if (wid == 0) {
                    const int v = (int)__builtin_amdgcn_readfirstlane(tk);
                    bool ok = false;
                    if (v < IT_END) { const Unit q = decode(v); ok = q.kind <= K_P8 && deps_ready(q, ctl); }
                    if (lane == 0) { misc[0] = (unsigned)v; misc[2] = ok ? 1u : 0u; }
                    LDS_WAIT();
                }
                asm volatile("" ::: "memory"); PG8_BAR; asm volatile("" ::: "memory");
                next_ticket = (int)__builtin_amdgcn_readfirstlane(misc[0]);
                has_next = __builtin_amdgcn_readfirstlane(misc[2]) != 0u;
                if (has_next) { nxt = decode(next_ticket); int Kn; kind_operands(nxt.kind, ws, nA, nB, Kn); kbn = (unsigned)Kn * 2u; nA += (size_t)nxt.pm * 256 * kbn; nB += (size_t)nxt.pn * 256 * kbn; }
            }
            const size_t hs = (size_t)HALF * kb;
            const char* a1 = cA + (size_t)(t + 1) * 128;
            const char* a2 = last ? nA : cA + (size_t)(t + 2) * 128; const char* b2 = last ? nB : cB + (size_t)(t + 2) * 128;
            const unsigned kb2 = last ? kbn : kb; const size_t hs2 = (size_t)HALF * kb2;
            const char* a3 = a2 + 128; const char* b3 = b2 + 128;
            PG8_LDB(B0, 0, 0); PG8_LDB(B1, 0, 1); PG8_SCHED; PG8_LDA(At, 0, 0); PG8_STAGE_A(PG8_SA(1, 1), a1 + hs, kb);
            PG8_WAIT_V(8); PG8_WAIT_L(0); PG8_BAR; PG8_MMA(0, 0, At, B0); PG8_MMA(0, 1, At, B1); PG8_BAR; PG8_SCHED;
            PG8_LDA(At, 0, 1); PG8_STAGE_B(PG8_SB(0, 0), b2, kb2); PG8_STAGE_B(PG8_SB(0, 1), b2 + hs2, kb2); PG8_STAGE_A(PG8_SA(0, 0), a2, kb2);
            PG8_WAIT_V(8); PG8_WAIT_L(0); PG8_BAR; PG8_MMA(1, 0, At, B0); PG8_MMA(1, 1, At, B1); PG8_BAR; PG8_SCHED;
            PG8_LDB(B0, 1, 0); PG8_LDB(B1, 1, 1); PG8_SCHED; PG8_LDA(At, 1, 0); PG8_STAGE_A(PG8_SA(0, 1), a2 + hs2, kb2);
            PG8_WAIT_V(8); PG8_WAIT_L(0); PG8_BAR; PG8_MMA(0, 0, At, B0); PG8_MMA(0, 1, At, B1); PG8_BAR; PG8_SCHED;
            PG8_LDA(At, 1, 1); PG8_STAGE_B(PG8_SB(1, 0), b3, kb2); PG8_STAGE_B(PG8_SB(1, 1), b3 + hs2, kb2); PG8_STAGE_A(PG8_SA(1, 0), a3, kb2);
            PG8_WAIT_V(8); PG8_WAIT_L(0); PG8_BAR; PG8_MMA(1, 0, At, B0); PG8_MMA(1, 1, At, B1); PG8_BAR; PG8_SCHED;
        }
        if (wr == 0) PG8_BAR;
        PROF_END(misc, 2); PROF_BEGIN(misc, 3);
        if ((PROF_CAT == 14 || PROF_CAT == 15) && threadIdx.x == 0 && cur.kind == PROF_KIND) { const unsigned d_ = PROF_NOW() - misc[34];
            if (PROF_CAT == 14) { if (d_ > misc[16]) misc[16] = d_; } else { if (misc[16] == 0u || d_ < misc[16]) misc[16] = d_; } }
        run_epilogue(acc, cur, wr, wc, fr, fq, ws, xin0, xin1, X);
        VM_WAIT();
        if (lane == 0) __hip_atomic_fetch_add(ctl + cw_done(done_slot(cur.kind), cur.pm), 1u, RLX_AGENT);
        PROF_END(misc, 3); PROF_BEGIN(misc, 2);
        if ((PROF_CAT == 14 || PROF_CAT == 15) && threadIdx.x == 0) misc[34] = PROF_NOW();
        if (!has_next) break;
#pragma unroll
        for (int a = 0; a < 2; ++a)
#pragma unroll
            for (int b = 0; b < 2; ++b)
#pragma unroll
                for (int m = 0; m < 4; ++m)
#pragma unroll
                    for (int n = 0; n < 2; ++n) acc[a][b][m][n] = (f32x4){0.f, 0.f, 0.f, 0.f};
        cur = nxt; cA = nA; cB = nB; kb = kbn; nt = (int)(kb >> 7);
        if (wr == 1) PG8_BAR;
    }
    PG8_WAIT_V(0);
    PG8_BAR;
    PROF_END(misc, 2);
    return next_ticket;
#undef PG8_SA
#undef PG8_SB
#undef PG8_STAGE_A
#undef PG8_STAGE_B
#undef PG8_LDA
#undef PG8_LDB
#undef PG8_MMA
#undef PG8_WAIT_V
#undef PG8_WAIT_L
#undef PG8_BAR
#undef PG8_SCHED
}
}

constexpr int LDS_STAGE = pg8::STAGE_BYTES, P4_RED = 126976, P4_FIN = 128000, P4_ATILE = 128256, MISC_OFF = P4_ATILE + 64 * 528, LDS_BYTES = MISC_OFF + 256;
static_assert(LDS_BYTES <= 160 * 1024, "LDS");

struct Args { const float* in[25]; float* out; unsigned char* ws; };
typedef const Args __attribute__((address_space(4)))* ArgsP;
#define ARG_IN(i) ((const float*)(const GAS float*)ap->in[i])
#define ARG_OUT ((float*)(GAS float*)ap->out)
#define ARG_WS ((unsigned char*)(GAS unsigned char*)ap->ws)

__device__ __forceinline__ int map_row(int n, int rmap) {
    if (rmap == 1) { const int up = n >= DFF, j = up ? n - DFF : n; return ((j >> 7) << 8) + (up << 7) + (j & 127); }
    if (rmap == 2) { if (n >= 2048) return n; const int gt = n >= 1024, j = gt ? n - 1024 : n; return ((j >> 7) << 8) + (gt << 7) + (j & 127); }
    return n;
}
template <bool WTHRU> __device__ __forceinline__ void p0_transpose_item(const float* W, int K, int N, bf16_t* WT, int rmap, const float* gain, LAS float* scr, int item, int lane) {
    const int nblk = N / 32, kb = item / nblk, nb = item % nblk, k0 = 64 * kb, n0 = 32 * nb;
    const int n4 = (lane & 7) * 4;
#pragma unroll
    for (int i = 0; i < 8; ++i) {
        const int kk = i * 8 + (lane >> 3);
        f32x4 v = *(const f32x4*)(W + (size_t)(k0 + kk) * N + n0 + n4);
        if (gain) v = v * gain[k0 + kk];
        LAS float* s = scr + kk * 33 + n4;
        s[0] = v[0]; s[1] = v[1]; s[2] = v[2]; s[3] = v[3];
    }
    LDS_WAIT(); asm volatile("" ::: "memory");
    const int c = lane >> 3;
    const int d0 = map_row(n0, rmap);
#pragma unroll
    for (int j = 0; j < 4; ++j) { const int n = (lane & 7) + 8 * j; const LAS float* s = scr + (8 * c) * 33 + n;
        u32x4 o; o.x = cvt_pk_bf16(s[0 * 33], s[1 * 33]); o.y = cvt_pk_bf16(s[2 * 33], s[3 * 33]); o.z = cvt_pk_bf16(s[4 * 33], s[5 * 33]); o.w = cvt_pk_bf16(s[6 * 33], s[7 * 33]);
        if (WTHRU) st16_wt(WT + (size_t)(d0 + n) * K + k0 + 8 * c, o); else *(u32x4*)(WT + (size_t)(d0 + n) * K + k0 + 8 * c) = o; }
    LDS_WAIT(); asm volatile("" ::: "memory");
}

__device__ __forceinline__ void p0_prologue(ArgsP ap, LAS unsigned char* lds, int tid, int G) {
    const int lane = tid & 63, wave = __builtin_amdgcn_readfirstlane(tid >> 6);
    LAS float* scr = (LAS float*)(lds + wave * 8448);
    const int gw = blockIdx.x * NWAVES + wave, NGW = G * NWAVES;
    unsigned char* ws = ARG_WS;
    constexpr int I_FI = (D / 64) * (2 * DFF / 32);
    for (int it = gw; it < I_FI; it += NGW) p0_transpose_item<false>(ARG_IN(7), D, 2 * DFF, (bf16_t*)(ws + WS_W1IN), 1, ARG_IN(6), scr, it, lane);
    constexpr int I_FO = (DFF / 64) * (D / 32);
    for (int it = gw; it < I_FO; it += NGW) p0_transpose_item<false>(ARG_IN(8), DFF, D, (bf16_t*)(ws + WS_W1OUT), 0, nullptr, scr, it, lane);
    bf16_t* XNB = (bf16_t*)(ws + WS_XA); bf16_t* PB = (bf16_t*)(ws + WS_PB); float* SS = (float*)(ws + WS_SS);
    for (int r = gw; r < NTOK; r += NGW) {
        const float* xr = r < NPROMPT ? ARG_IN(0) + (size_t)r * D : ARG_IN(1) + (size_t)(r - NPROMPT) * D;
        float sq = 0.f;
#pragma unroll
        for (int j = 0; j < 8; ++j) { const f32x4 v = *(const f32x4*)(xr + 4 * lane + 256 * j);
            sq += (v[0] * v[0] + v[1] * v[1]) + (v[2] * v[2] + v[3] * v[3]);
            u32x2 w; w.x = cvt_pk_bf16(v[0], v[1]); w.y = cvt_pk_bf16(v[2], v[3]);
            *(u32x2*)(XNB + (size_t)r * D + 4 * lane + 256 * j) = w; }
        sq = wave_sum(sq);
        if (lane == 0) SS[r] = sq;
        const float* pr = r < NPROMPT ? ARG_IN(4) + (size_t)r * PLE : ARG_IN(5) + (size_t)(r - NPROMPT) * PLE;
        const f32x4 v = *(const f32x4*)(pr + 4 * lane);
        u32x2 w; w.x = cvt_pk_bf16(v[0], v[1]); w.y = cvt_pk_bf16(v[2], v[3]);
        *(u32x2*)(PB + (size_t)r * PLE + 4 * lane) = w;
    }
    {
        const u32x4 z = {0u, 0u, 0u, 0u};
        const size_t gt = (size_t)blockIdx.x * NTHREADS + tid, GT = (size_t)G * NTHREADS;
        u32x4* p; size_t n;
        p = (u32x4*)(ws + WS_XA + (size_t)NTOK * D * 2); n = (size_t)(MP - NTOK) * D * 2 / 16; for (size_t i = gt; i < n; i += GT) p[i] = z;
        p = (u32x4*)(ws + WS_XB + (size_t)NTOK * D * 2); n = (size_t)(MP - NTOK) * D * 2 / 16; for (size_t i = gt; i < n; i += GT) p[i] = z;
        p = (u32x4*)(ws + WS_ACT + (size_t)NTOK * DFF * 2); n = (size_t)(MP - NTOK) * DFF * 2 / 16; for (size_t i = gt; i < n; i += GT) p[i] = z;
        p = (u32x4*)(ws + WS_PB + (size_t)NTOK * PLE * 2); n = (size_t)(MP - NTOK) * PLE * 2 / 16; for (size_t i = gt; i < n; i += GT) p[i] = z;
        p = (u32x4*)(ws + WS_SS + (size_t)MP * 4); n = (size_t)4 * MP * 4 / 16; for (size_t i = gt; i < n; i += GT) p[i] = z;
    }
}

template <int W> __device__ __forceinline__ void pool_d_prompt(const float* U, int b, int t0r, int ch, LAS unsigned char* arow) {
    f32x2 xr[W + 15];
#pragma unroll
    for (int k = 0; k < W + 15; ++k) { const int t = t0r - (W - 1) + k; const f32x2 v = ld8_sc1(U + (size_t)(b * SEQ + (t > 0 ? t : 0)) * PDIM + ch); xr[k] = t >= 0 ? v : (f32x2){0.f, 0.f}; }
#pragma unroll
    for (int tt = 0; tt < 16; ++tt) { f32x2 s = xr[tt];
#pragma unroll
        for (int k = 1; k < W; ++k) s += xr[tt + k];
        const int t = t0r + tt; const float cnt = (float)(t + 1 < W ? t + 1 : W);
        const f32x2 dd = s / cnt - xr[tt + W - 1];
        *(LAS unsigned*)(arow + tt * 528) = cvt_pk_bf16(dd[0], dd[1]); }
}
template <int W> __device__ __forceinline__ void pool_d_sample(const float* U, const float* state, int b0r, int ch, LAS unsigned char* arow) {
#pragma unroll 4
    for (int tt = 0; tt < 16; ++tt) { const int b = b0r + tt; const f32x2 uc = ld8_sc1(U + (size_t)(NPROMPT + b) * PDIM + ch); f32x2 s = uc;
#pragma unroll
        for (int i = 1; i < W; ++i) s += *(const f32x2*)(state + ((size_t)b * 15 + (15 - i)) * PDIM + ch);
        const f32x2 dd = s * (1.0f / (float)W) - uc;
        *(LAS unsigned*)(arow + tt * 528) = cvt_pk_bf16(dd[0], dd[1]); }
}

template <int R> __device__ __forceinline__ void p4_conv_unit(int r0, const float* V, const float* state_conv, bf16_t* MIX, f32x2 cb, f32x2 lg, f32x2 lb, LAS unsigned char* lds, int tid, int lane, int wave) {
    const int c0 = 2 * tid;
    const LAS f32x2* wl = (const LAS f32x2*)(lds) + tid;
    f32x2 o[R];
    if constexpr (R == 16) {
        const int b = r0 >> 11, t0 = r0 & (SEQ - 1);
        f32x2 x[46];
#pragma unroll
        for (int k = 0; k < 46; ++k) { const int t = t0 - 30 + k; const f32x2 v = ld8_sc1(V + (size_t)(b * SEQ + (t > 0 ? t : 0)) * CDIM + c0); x[k] = t >= 0 ? v : (f32x2){0.f, 0.f}; }
#pragma unroll
        for (int tt = 0; tt < 16; ++tt) o[tt] = cb;
#pragma unroll
        for (int j = 0; j < 31; ++j) { const f32x2 wj = wl[j * 512];
#pragma unroll
            for (int tt = 0; tt < 16; ++tt) o[tt] += wj * x[tt + j]; }
    } else {
        f32x2 x[R][31];
#pragma unroll
        for (int tt = 0; tt < R; ++tt) {
#pragma unroll
            for (int j = 0; j < 30; ++j) x[tt][j] = *(const f32x2*)(state_conv + ((size_t)(r0 - NPROMPT + tt) * 30 + j) * CDIM + c0);
            x[tt][30] = ld8_sc1(V + (size_t)(r0 + tt) * CDIM + c0); }
#pragma unroll
        for (int tt = 0; tt < R; ++tt) o[tt] = cb;
#pragma unroll
        for (int j = 0; j < 31; ++j) { const f32x2 wj = wl[j * 512];
#pragma unroll
            for (int tt = 0; tt < R; ++tt) o[tt] += wj * x[tt][j]; }
    }
    constexpr int NV = 2 * R, SH = (NV == 32 ? 1 : NV == 4 ? 4 : NV == 2 ? 5 : -1); static_assert(SH > 0, "R is 16, 2 or 1");
    float p[NV];
#pragma unroll
    for (int tt = 0; tt < R; ++tt) { p[2 * tt] = o[tt][0] + o[tt][1]; p[2 * tt + 1] = o[tt][0] * o[tt][0] + o[tt][1] * o[tt][1]; }
#pragma unroll
    for (int h = NV / 2, off = 32; h >= 1; h >>= 1, off >>= 1) {
        const bool up = (lane & off) != 0;
#pragma unroll
        for (int i = 0; i < h; ++i) { const float keep = up ? p[i + h] : p[i], send = up ? p[i] : p[i + h]; p[i] = keep + __shfl_xor(send, off); }
    }
#pragma unroll
    for (int off = (1 << SH) >> 1; off >= 1; off >>= 1) p[0] += __shfl_xor(p[0], off);
    LAS float* red = (LAS float*)(lds + P4_RED); LAS f32x2* fin = (LAS f32x2*)(lds + P4_FIN);
    if ((lane & ((1 << SH) - 1)) == 0) red[wave * 32 + (lane >> SH)] = p[0];
    __syncthreads();
    if (tid < R) { float s1 = 0.f, s2 = 0.f;
#pragma unroll
        for (int wv = 0; wv < 8; ++wv) { s1 += red[wv * 32 + 2 * tid]; s2 += red[wv * 32 + 2 * tid + 1]; }
        const float mean = s1 * (1.0f / CDIM), var = s2 * (1.0f / CDIM) - mean * mean;
        fin[tid] = (f32x2){mean, __builtin_amdgcn_rsqf(var + EPS)}; }
    __syncthreads();
#pragma unroll
    for (int tt = 0; tt < R; ++tt) {
        const f32x2 mr = fin[tt];
        const float y0 = (o[tt][0] - mr[0]) * mr[1] * lg[0] + lb[0], y1 = (o[tt][1] - mr[0]) * mr[1] * lg[1] + lb[1];
        st4_wt(MIX + (size_t)(r0 + tt) * D + c0, cvt_pk_bf16(y0 * sigmoidf_fast(y0), y1 * sigmoidf_fast(y1)));
    }
    __syncthreads();
}

__device__ __forceinline__ void p4_pool_unit(int r0, int g, const float* U, const float* state_pool, const bf16_t* PWT, const float* pscale, bf16_t* MIX, LAS unsigned char* lds, int tid, int lane, int wave) {
    const int cp = tid & 127, rq = __builtin_amdgcn_readfirstlane(tid >> 7), fr = lane & 15, fq = lane >> 4, ch = g * 256 + 2 * cp;
    LAS unsigned char* atile = lds + P4_ATILE;
    bf16x8 bfr[2][8];
    const bf16_t* wb = PWT + ((size_t)(g * 256 + 32 * wave + fr) * 256 + fq * 8);
#define P4_LOAD_B() do { _Pragma("unroll") for (int nf = 0; nf < 2; ++nf) _Pragma("unroll") for (int ks = 0; ks < 8; ++ks) bfr[nf][ks] = *(const bf16x8*)(wb + (size_t)nf * 16 * 256 + ks * 32); } while (0)
    LAS unsigned char* arow = atile + (16 * rq) * 528 + 4 * cp;
    if (r0 < NPROMPT) {
        P4_LOAD_B();
        const int b = r0 >> 11, t0r = (r0 & (SEQ - 1)) + 16 * rq;
        if (g == 0) pool_d_prompt<2>(U, b, t0r, ch, arow); else if (g == 1) pool_d_prompt<4>(U, b, t0r, ch, arow);
        else if (g == 2) pool_d_prompt<8>(U, b, t0r, ch, arow); else pool_d_prompt<16>(U, b, t0r, ch, arow);
    } else {
        const int b0r = r0 - NPROMPT + 16 * rq;
        if (g == 0) pool_d_sample<2>(U, state_pool, b0r, ch, arow); else if (g == 1) pool_d_sample<4>(U, state_pool, b0r, ch, arow);
        else if (g == 2) pool_d_sample<8>(U, state_pool, b0r, ch, arow); else pool_d_sample<16>(U, state_pool, b0r, ch, arow);
        P4_LOAD_B();
    }
#undef P4_LOAD_B
    __syncthreads();
    f32x4 acc[4][2];
#pragma unroll
    for (int mf = 0; mf < 4; ++mf)
#pragma unroll
        for (int nf = 0; nf < 2; ++nf) acc[mf][nf] = (f32x4){0.f, 0.f, 0.f, 0.f};
#pragma unroll
    for (int ks = 0; ks < 8; ++ks)
#pragma unroll
        for (int mf = 0; mf < 4; ++mf) {
            const bf16x8 af = *(const LAS bf16x8*)(atile + (mf * 16 + fr) * 528 + ks * 64 + fq * 16);
#pragma unroll
            for (int nf = 0; nf < 2; ++nf) acc[mf][nf] = __builtin_amdgcn_mfma_f32_16x16x32_bf16(bfr[nf][ks], af, acc[mf][nf], 0, 0, 0);
        }
#pragma unroll
    for (int nf = 0; nf < 2; ++nf) { const int cg_ = g * 256 + 32 * wave + nf * 16 + 4 * fq; const f32x4 sc = *(const f32x4*)(pscale + cg_);
#pragma unroll
        for (int mf = 0; mf < 4; ++mf) { const f32x4 y = acc[mf][nf] * sc;
            u32x2 ov; ov.x = cvt_pk_bf16(y[0], y[1]); ov.y = cvt_pk_bf16(y[2], y[3]);
            st8_wt(MIX + (size_t)(r0 + mf * 16 + fr) * D + CDIM + cg_, ov); } }
    __syncthreads();
}

__device__ __forceinline__ void p4_copy_src(int it, const float* V, const float* U, const float* state_conv, const float* state_pool, float* out, const float*& src, float*& dst, int& srcpm) {
    constexpr int R0 = NBATCH * 30, R1 = R0 + NSAMP * 30, R2 = R1 + NBATCH * 15;
    srcpm = -1;
    if (it < R0) { const int b = it / 30, i = it % 30; src = V + (size_t)(b * SEQ + SEQ - 30 + i) * CDIM; dst = out + OUT_NCP + (size_t)it * CDIM; srcpm = 8 * b + 7; }
    else if (it < R1) { const int q = it - R0, b = q / 30, i = q % 30; if (i < 29) src = state_conv + ((size_t)b * 30 + i + 1) * CDIM; else { src = V + (size_t)(NPROMPT + b) * CDIM; srcpm = 32; } dst = out + OUT_NCS + (size_t)q * CDIM; }
    else if (it < R2) { const int q = it - R1, b = q / 15, i = q % 15; src = U + (size_t)(b * SEQ + SEQ - 15 + i) * PDIM; dst = out + OUT_NPP + (size_t)q * PDIM; srcpm = 8 * b + 7; }
    else { const int q = it - R2, b = q / 15, i = q % 15; if (i < 14) src = state_pool + ((size_t)b * 15 + i + 1) * PDIM; else { src = U + (size_t)(NPROMPT + b) * PDIM; srcpm = 32; } dst = out + OUT_NPS + (size_t)q * PDIM; }
}

__device__ __forceinline__ bool try_filler(ArgsP ap, LAS unsigned char* lds, volatile LAS unsigned* MISC, unsigned* ctl, int tid) {
    const int lane = tid & 63, wave = __builtin_amdgcn_readfirstlane(tid >> 6);
    if (tid == 0) MISC[5] = __hip_atomic_fetch_add(ctl + CW_FHEAD, 1u, RLX_AGENT);
    __syncthreads();
    const int f = (int)__builtin_amdgcn_readfirstlane(MISC[5]);
    __syncthreads();
    if (f >= NFILL) return false;
    unsigned char* ws = ARG_WS;
    LAS float* scr = (LAS float*)(lds + wave * 8448);
    int m, bi;
    if (f < cm_start(1)) { m = 0; bi = f; } else if (f < cm_start(2)) { m = 1; bi = f - cm_start(1); } else if (f < cm_start(3)) { m = 2; bi = f - cm_start(2); } else if (f < cm_start(4)) { m = 3; bi = f - cm_start(3); }
    else if (f < cm_start(5)) { m = 4; bi = f - cm_start(4); } else if (f < cm_start(6)) { m = 5; bi = f - cm_start(5); } else if (f < cm_start(7)) { m = 6; bi = f - cm_start(6); } else { m = 7; bi = f - cm_start(7); }
#define FILL(SRC, KK, NN, DSTOFF, RMAP, GAIN) do { const int nb256 = (NN) / 256, kb = bi / nb256, nb = bi - kb * nb256; \
        p0_transpose_item<true>(SRC, KK, NN, (bf16_t*)(ws + (DSTOFF)), RMAP, GAIN, scr, kb * ((NN) / 32) + nb * 8 + wave, lane); } while (0)
    switch (m) {
        case CM_W1OUT: FILL(ARG_IN(8), DFF, D, WS_W1OUT, 0, (const float*)nullptr); break;
        case CM_WIN:   FILL(ARG_IN(10), D, 3072, WS_WIN, 2, ARG_IN(9)); break;
        case CM_PW:    { const int g = bi >> 2, kb = bi & 3; p0_transpose_item<true>(ARG_IN(15) + (size_t)g * 65536, 256, 256, (bf16_t*)(ws + WS_PW) + (size_t)g * 65536, 0, nullptr, scr, kb * 8 + wave, lane); } break;
        case CM_WOUT:  FILL(ARG_IN(17), D, D, WS_WOUT, 0, (const float*)nullptr); break;
        case CM_W2IN:  FILL(ARG_IN(19), D, 2 * DFF, WS_W2IN, 1, ARG_IN(18)); break;
        case CM_W2OUT: FILL(ARG_IN(20), DFF, D, WS_W2OUT, 0, (const float*)nullptr); break;
        case CM_WPP:   FILL(ARG_IN(23), PLE, D, WS_WPP, 0, (const float*)nullptr); break;
        default:       FILL(ARG_IN(22), D, D, WS_WPG, 0, ARG_IN(21)); break;
    }
#undef FILL
    VM_WAIT(); __syncthreads();
    if (tid == 0) __hip_atomic_fetch_add(ctl + cw_done(SL_CONV, m), 1u, RLX_AGENT);
    return true;
}
__device__ __forceinline__ bool item_ready(const pg8::Unit& u, unsigned* ctl) {
    if (u.kind <= K_P8) return pg8::deps_ready(u, ctl);
    if (u.kind == T_P4) {
        const int pm = u.pm; const bool pool = (pm == 32) ? (u.pn >= P4_S_CONV) : (u.pn >= 16);
        return ld_cnt(ctl + cw_done(SL_P3, pm)) >= 96u && (pm == 32 || (pm & 7) == 0 || ld_cnt(ctl + cw_done(SL_P3, pm - 1)) >= 96u) && (!pool || pg8::conv_ready(ctl, CM_PW));
    }
    if (u.kind == T_P4COPY)
        return ld_cnt(ctl + cw_done(SL_P3, 7)) >= 96u && ld_cnt(ctl + cw_done(SL_P3, 15)) >= 96u && ld_cnt(ctl + cw_done(SL_P3, 23)) >= 96u && ld_cnt(ctl + cw_done(SL_P3, 31)) >= 96u && ld_cnt(ctl + cw_done(SL_P3, 32)) >= 96u;
    return ld_cnt(ctl + cw_done(SL_P8, u.pm)) >= 64u;
}
#define BLOCK_WAIT(COND) do { unsigned sp_ = 0u; if (PROF_CAT >= 9 && PROF_CAT <= 12 && tid == 0) MISC[33] = 0u; for (;;) { \
        if (tid == 0) MISC[4] = (COND) ? 1u : 0u; \
        __syncthreads(); const unsigned ok_ = MISC[4]; __syncthreads(); \
        if (ok_) break; \
        { unsigned tf0_ = 0u; if (PROF_CAT >= 8 && PROF_CAT <= 12) tf0_ = PROF_NOW(); const bool did_ = fill_left && try_filler(ap, lds, MISC, ctl, tid); if (PROF_CAT >= 8 && PROF_CAT <= 12 && did_ && tid == 0) { const unsigned d_ = PROF_NOW() - tf0_; if (PROF_CAT == 8) MISC[16] += d_; else MISC[33] += d_; } if (did_) { convw_ready = false; continue; } } \
        fill_left = false; __builtin_amdgcn_s_sleep(8); \
        if ((++sp_ & 63u) == 0u) { if (ld_cnt(ctl + CW_TMO) != 0u) break; if (sp_ > (1u << 16)) { if (tid == 0) __hip_atomic_store(ctl + CW_TMO, 1u, RLX_AGENT); break; } } } } while (0)

__global__ void __launch_bounds__(NTHREADS, 2) fwd_kernel(Args args) {
    extern __shared__ __attribute__((aligned(16))) unsigned char lds_raw[];
    LAS unsigned char* lds = (LAS unsigned char*)lds_raw;
    volatile LAS unsigned* MISC = (volatile LAS unsigned*)(lds + MISC_OFF);
    ArgsP ap = (ArgsP)__builtin_amdgcn_kernarg_segment_ptr();
    const int tid = threadIdx.x, G = gridDim.x, lane = tid & 63, wave = __builtin_amdgcn_readfirstlane(tid >> 6);
    unsigned char* ws = ARG_WS;
    unsigned* ctl = (unsigned*)(ws + WS_CTL);

    if (PROF_CAT >= 0 && tid < 64) { MISC[tid] = 0u; } __syncthreads();
    if (PROF_CAT >= 0 && tid == 0) { const unsigned t_ = PROF_NOW(); MISC[3] = t_; MISC[32] = t_; }
    PROF_BEGIN(MISC, 0);
    p0_prologue(ap, lds, tid, G);
    PROF_END(MISC, 0); PROF_BEGIN(MISC, 1);
    cg::this_grid().sync();
    PROF_END(MISC, 1);

    bool convw_ready = false;
    bool fill_left = true;
    int ticket;
    if (tid == 0) MISC[1] = __hip_atomic_fetch_add(ctl + CW_HEAD, 1u, RLX_AGENT);
    __syncthreads();
    ticket = (int)__builtin_amdgcn_readfirstlane(MISC[1]);
    const int tid0 = tid; ArgsP const ap0 = ap;
    while (ticket < IT_END) {
        int tid = tid0; asm volatile("" : "+v"(tid));
        ArgsP ap = ap0; asm volatile("" : "+s"(ap));
        const int lane = tid & 63, wave = __builtin_amdgcn_readfirstlane(tid >> 6);
        unsigned char* ws = ARG_WS; unsigned* ctl = (unsigned*)(ws + WS_CTL);
        float* X = ARG_OUT;
        const float* V = (const float*)(ws + WS_V); const float* U = (const float*)(ws + WS_U);
        bf16_t* XA = (bf16_t*)(ws + WS_XA);
        const pg8::Unit item = pg8::decode(ticket);
        PROF_BEGIN(MISC, 6); if (PROF_CAT >= 9 && PROF_CAT <= 12 && tid == 0) MISC[32] = PROF_NOW();
        BLOCK_WAIT(item_ready(item, ctl));
        PROF_END(MISC, 6);
        if (PROF_CAT >= 9 && PROF_CAT <= 12 && tid == 0 && PROF_CAT == (item.kind <= K_P3 ? 9 : item.kind <= K_P8 ? 11 : item.kind == T_P9 ? 12 : 10)) MISC[16] += PROF_NOW() - MISC[32] - MISC[33];
        if (PROF_CAT == 13 && tid == 0 && item.kind <= K_P8) MISC[16] += 100u;
        if (item.kind <= K_P8) {
            __syncthreads();
            ticket = pg8::gemm_stream(lds, MISC, ws, ctl, ARG_IN(0), ARG_IN(1), X, ticket);
            convw_ready = false;
            __syncthreads();
            continue;
        }
        PROF_BEGIN(MISC, 5);
        unsigned nxt_tk = 0u;
        if (tid == 0) nxt_tk = __hip_atomic_fetch_add(ctl + CW_HEAD, 1u, RLX_AGENT);
        if (item.kind == T_P4) {
            const int pm = item.pm;
            const int kind = (pm == 32) ? (item.pn >= P4_S_CONV ? 1 : 0) : (item.pn >> 4), sub = (pm == 32) ? (kind ? item.pn - P4_S_CONV : item.pn) : (item.pn & 15);
            if (kind == 0) {
                if (!convw_ready) {
                    const float* cw = ARG_IN(11); f32x4 t[16];
#pragma unroll
                    for (int q = 0; q < 16; ++q) { const int i = tid + q * NTHREADS; t[q] = *(const f32x4*)(cw + 4 * (i < 31 * CDIM / 4 ? i : 0)); }
#pragma unroll
                    for (int q = 0; q < 16; ++q) { const int i = tid + q * NTHREADS; if (i < 31 * CDIM / 4) *(LAS f32x4*)(lds + 16 * i) = t[q]; }
                    convw_ready = true; __syncthreads();
                }
                const int c0 = 2 * tid;
                const f32x2 cb = *(const f32x2*)(ARG_IN(12) + c0), lg = *(const f32x2*)(ARG_IN(13) + c0), lb = *(const f32x2*)(ARG_IN(14) + c0);
                if (pm == 32) {
#pragma nounroll
                    for (int s = 0; s < 4; ++s) p4_conv_unit<1>(NPROMPT + 4 * sub + s, V, ARG_IN(2), XA, cb, lg, lb, lds, tid, lane, wave);
                } else p4_conv_unit<16>(256 * pm + 16 * sub, V, ARG_IN(2), XA, cb, lg, lb, lds, tid, lane, wave);
            } else {
                const int r0 = (pm == 32) ? NPROMPT + 64 * (sub >> 2) : 256 * pm + 64 * (sub >> 2);
                p4_pool_unit(r0, sub & 3, U, ARG_IN(3), (const bf16_t*)(ws + WS_PW), ARG_IN(16), XA, lds, tid, lane, wave);
            }
            VM_WAIT(); __syncthreads();
            if (tid == 0) __hip_atomic_fetch_add(ctl + cw_done(SL_P4, pm), 1u, RLX_AGENT);
        } else if (item.kind == T_P4COPY) {
            const int base = item.pn * 64;
#pragma nounroll
            for (int q = 0; q < 8; ++q) {
                const int row = base + wave * 8 + q;
                if (row < P4_NCOPYROWS) {
                    const float* src; float* dst; int srcpm; p4_copy_src(row, V, U, ARG_IN(2), ARG_IN(3), X, src, dst, srcpm);
                    if (srcpm >= 0) {
#pragma unroll
                        for (int j = 0; j < 8; ++j) { const f32x2 v = ld8_sc1(src + 2 * lane + 128 * j); *(f32x2*)(dst + 2 * lane + 128 * j) = v; }
                    } else {
#pragma unroll
                        for (int j = 0; j < 4; ++j) *(f32x4*)(dst + 4 * lane + 256 * j) = *(const f32x4*)(src + 4 * lane + 256 * j);
                    }
                }
            }
        } else {
            const int r0 = 256 * item.pm + 16 * item.pn;
            const float* ss4 = (const float*)(ws + WS_SS) + (size_t)4 * MP; const float* gn = ARG_IN(24);
            const f32x4 gg = *(const f32x4*)(gn + 4 * tid);
#pragma unroll 4
            for (int q = 0; q < 16; ++q) {
                const int r = r0 + q;
                const float rs = __builtin_amdgcn_rsqf(__hip_atomic_load(ss4 + r, RLX_AGENT) * (1.0f / D) + EPS);
                float* xp = X + (size_t)r * D + 4 * tid;
                const f32x2 a0 = ld8_sc1(xp), a1 = ld8_sc1(xp + 2);
                *(f32x4*)xp = (f32x4){a0[0] * rs * gg[0], a0[1] * rs * gg[1], a1[0] * rs * gg[2], a1[1] * rs * gg[3]};
            }
        }
        PROF_END(MISC, 5);
        __syncthreads();
        if (tid == 0) MISC[1] = nxt_tk;
        __syncthreads();
        ticket = (int)__builtin_amdgcn_readfirstlane(MISC[1]);
    }
    if (PROF_CAT >= 0 && tid0 == 0) {
        const unsigned tfin = PROF_NOW();
        if (PROF_CAT == 14) __hip_atomic_fetch_max(ctl + CW_PROF + 0, MISC[16], RLX_AGENT); else if (PROF_CAT == 15) __hip_atomic_fetch_max(ctl + CW_PROF + 0, 0xffffffffu - (MISC[16] ? MISC[16] : 0xfffffffeu), RLX_AGENT); else
        __hip_atomic_fetch_add(ctl + CW_PROF + 0, MISC[16], RLX_AGENT);
        __hip_atomic_fetch_add(ctl + CW_PROF + 7, tfin - MISC[3], RLX_AGENT);
        asm volatile("s_waitcnt vmcnt(0)" ::: "memory");
        const unsigned fin = __hip_atomic_fetch_add(ctl + CW_FIN, 1u, RLX_AGENT);
        if (fin == (unsigned)G - 1u) {
            unsigned avg;
            if (PROF_CAT == 14) avg = ld_cnt(ctl + CW_PROF + 0); else if (PROF_CAT == 15) avg = 0xffffffffu - ld_cnt(ctl + CW_PROF + 0); else
            if (PROF_CAT != 7) avg = ld_cnt(ctl + CW_PROF + 0) / (unsigned)G;
            else avg = (tfin - MISC[3]) - ld_cnt(ctl + CW_PROF + 7) / (unsigned)G;
            const unsigned tgt = avg * PROF_MULT;
            while (PROF_NOW() - tfin < tgt) __builtin_amdgcn_s_sleep(8);
        }
    }
}

extern "C" void kernel_launch(void* const* d_in, const int* in_sizes, int n_in, void* d_out, int out_size, void* d_ws, size_t ws_size, hipStream_t stream) {
    static int grid = 0;
    if (grid == 0) {
        if (n_in != 25 || (size_t)out_size != OUT_END || ws_size < WS_END) {
            fprintf(stderr, "kernel_launch: built for 25 inputs, %zu outputs, >= %zu bytes of workspace; got n_in %d, out %d, ws %zu; nothing launched\n", (size_t)OUT_END, (size_t)WS_END, n_in, out_size, ws_size);
            grid = -1; return; }
        int dev = 0, cus = 0, per_cu = 0;
        if (hipGetDevice(&dev) != hipSuccess || hipDeviceGetAttribute(&cus, hipDeviceAttributeMultiprocessorCount, dev) != hipSuccess) { fprintf(stderr, "kernel_launch: device query failed\n"); grid = -1; return; }
        if (hipFuncSetAttribute((const void*)fwd_kernel, hipFuncAttributeMaxDynamicSharedMemorySize, LDS_BYTES) != hipSuccess) { fprintf(stderr, "kernel_launch: hipFuncSetAttribute failed\n"); grid = -1; return; }
        if (hipOccupancyMaxActiveBlocksPerMultiprocessor(&per_cu, (const void*)fwd_kernel, NTHREADS, LDS_BYTES) != hipSuccess || per_cu < 1) { fprintf(stderr, "kernel_launch: occupancy query says %d blocks per CU\n", per_cu); (void)hipGetLastError(); per_cu = 1; }
        grid = cus * 1;
        fprintf(stderr, "kernel_launch: %d CUs, occupancy query %d block(s)/CU, grid %d, LDS %d B, ws %zu B (need %zu)\n", cus, per_cu, grid, LDS_BYTES, ws_size, (size_t)WS_END);
    }
    if (grid < 0) return;
    if (hipMemsetAsync((char*)d_ws + WS_CTL, 0, CTL_BYTES, stream) != hipSuccess) { fprintf(stderr, "kernel_launch: memset failed\n"); return; }
    Args a{};
    for (int i = 0; i < 25; ++i) a.in[i] = (const float*)d_in[i];
    a.out = (float*)d_out; a.ws = (unsigned char*)d_ws;
    void* kargs[] = {&a};
    hipError_t e = hipLaunchCooperativeKernel((const void*)fwd_kernel, dim3(grid), dim3(NTHREADS), kargs, LDS_BYTES, stream);
    if (e != hipSuccess) fprintf(stderr, "kernel_launch: cooperative launch failed: %s (grid %d)\n", hipGetErrorString(e), grid);
}
```
